# Optimizing an MI355X kernel written in HIP

```python
import math
import jax, jax.numpy as jnp
from jax import lax
import numpy as np

D_MODEL = 1024
BATCH = 2
SEQ = 16384
DEPTH = 4

N_MIXERS = 2
N_CONV_LAYERS = (DEPTH + 1) // 2
N_ATTN_LAYERS = DEPTH // 2
D_FF = 2816
CONV_WIDTH = 3
HEAD_DIM = 64
N_Q_HEADS = D_MODEL // HEAD_DIM
N_KV_HEADS = 4
GROUP = N_Q_HEADS // N_KV_HEADS
WINDOW = 128
BLOCK = 128
ROPE_THETA = 10000.0
RMS_EPS = 1e-6

kernel_name = "hybrid_shortconv_swa_sink_macaron"


def rmsnorm(x, g):
    x32 = x.astype(jnp.float32)
    y = x32 * lax.rsqrt(jnp.mean(x32 * x32, axis=-1, keepdims=True) + RMS_EPS)
    return y.astype(x.dtype) * g


def swiglu(x, w_in, w_out):
    gate, up = jnp.split(x @ w_in, 2, axis=-1)
    return (jax.nn.silu(gate) * up) @ w_out


def short_conv_mixer(h, w_in, conv_k, w_out):
    S = h.shape[1]
    gate_b, gate_c, u = jnp.split(h @ w_in, 3, axis=-1)
    z = gate_c * u
    zp = jnp.pad(z, ((0, 0), (CONV_WIDTH - 1, 0), (0, 0)))
    conv = conv_k[0] * zp[:, 0:S]
    for tap in range(1, CONV_WIDTH):
        conv = conv + conv_k[tap] * zp[:, tap:tap + S]
    return (gate_b * conv) @ w_out


def rope_tables(positions, dtype):
    inv_freq = ROPE_THETA ** (-jnp.arange(0, HEAD_DIM, 2, dtype=jnp.float32) / HEAD_DIM)
    ang = positions.astype(jnp.float32)[..., None] * inv_freq
    return jnp.cos(ang)[:, :, None, :].astype(dtype), jnp.sin(ang)[:, :, None, :].astype(dtype)


def apply_rope(t, cos, sin):
    t1, t2 = jnp.split(t, 2, axis=-1)
    return jnp.concatenate([t1 * cos - t2 * sin, t2 * cos + t1 * sin], axis=-1)


def banded_keys(t, nb):
    B = t.shape[0]
    tb = t.reshape(B, nb, BLOCK, N_KV_HEADS, HEAD_DIM)
    prev = jnp.concatenate([jnp.zeros_like(tb[:, :1]), tb[:, :-1]], axis=1)
    return jnp.concatenate([prev, tb], axis=2)


def sliding_window_attention(h, positions, w_qkv, sinks, w_o):
    B, S, _ = h.shape
    nb = S // BLOCK
    qkv = h @ w_qkv
    q, k, v = jnp.split(qkv, [N_Q_HEADS * HEAD_DIM, (N_Q_HEADS + N_KV_HEADS) * HEAD_DIM], axis=-1)
    q = q.reshape(B, S, N_Q_HEADS, HEAD_DIM)
    k = k.reshape(B, S, N_KV_HEADS, HEAD_DIM)
    v = v.reshape(B, S, N_KV_HEADS, HEAD_DIM)
    cos, sin = rope_tables(positions, h.dtype)
    q = apply_rope(q, cos, sin)
    k = apply_rope(k, cos, sin)

    qb = q.reshape(B, nb, BLOCK, N_KV_HEADS, GROUP, HEAD_DIM)
    kw = banded_keys(k, nb)
    vw = banded_keys(v, nb)
    scale = 1.0 / math.sqrt(HEAD_DIM)
    s = jnp.einsum('bnqkgd,bnskd->bnkgqs', qb, kw).astype(jnp.float32) * scale

    qi = jnp.arange(BLOCK)[:, None]
    kj = jnp.arange(2 * BLOCK)[None, :]
    dist = qi + BLOCK - kj
    in_band = (dist >= 0) & (dist < WINDOW)
    blk = jnp.arange(nb)[:, None, None]
    mask = in_band[None] & ((blk > 0) | (kj >= BLOCK)[None])
    s = jnp.where(mask[None, :, None, None], s, jnp.finfo(jnp.float32).min)

    sink = jnp.broadcast_to(sinks.astype(jnp.float32).reshape(1, 1, N_KV_HEADS, GROUP, 1, 1),
                            s.shape[:-1] + (1,))
    p = jax.nn.softmax(jnp.concatenate([s, sink], axis=-1), axis=-1)[..., :-1].astype(h.dtype)
    o = jnp.einsum('bnkgqs,bnskd->bnqkgd', p, vw).reshape(B, S, N_Q_HEADS * HEAD_DIM)
    return o @ w_o


def setup_inputs(seed: int = 0) -> dict:
    key = jax.random.key(seed)
    ks = jax.random.split(key, 20)
    D, F = D_MODEL, D_FF
    qkv_w = (N_Q_HEADS + 2 * N_KV_HEADS) * HEAD_DIM

    def nrm(k, shape, fan_in):
        return jax.random.normal(k, shape, jnp.float32) * (fan_in ** -0.5)

    def gain(k, shape):
        return 1.0 + 0.05 * jax.random.normal(k, shape, jnp.float32)

    x = jax.random.normal(ks[0], (BATCH, SEQ, D), jnp.float32)
    positions = jnp.broadcast_to(jnp.arange(SEQ, dtype=jnp.int32)[None, :], (BATCH, SEQ))
    return {
        "x": x,
        "positions": positions,
        "ln_ff1": gain(ks[1], (DEPTH, D)),
        "w_ff1_in": nrm(ks[2], (DEPTH, D, 2 * F), D),
        "w_ff1_out": nrm(ks[3], (DEPTH, F, D), F),
        "ln_mix": gain(ks[4], (DEPTH, D)),
        "ln_ff2": gain(ks[5], (DEPTH, D)),
        "w_ff2_in": nrm(ks[6], (DEPTH, D, 2 * F), D),
        "w_ff2_out": nrm(ks[7], (DEPTH, F, D), F),
        "conv_w_in": nrm(ks[8], (N_CONV_LAYERS, D, 3 * D), D),
        "conv_kernel": nrm(ks[9], (N_CONV_LAYERS, CONV_WIDTH, D), CONV_WIDTH),
        "conv_w_out": nrm(ks[10], (N_CONV_LAYERS, D, D), D),
        "attn_w_qkv": nrm(ks[11], (N_ATTN_LAYERS, D, qkv_w), D),
        "attn_sinks": 0.5 * jax.random.normal(ks[12], (N_ATTN_LAYERS, N_Q_HEADS), jnp.float32),
        "attn_w_o": nrm(ks[13], (N_ATTN_LAYERS, N_Q_HEADS * HEAD_DIM, D), N_Q_HEADS * HEAD_DIM),
        "ln_final": gain(ks[14], (D,)),
    }


def reference(x, positions, ln_ff1, w_ff1_in, w_ff1_out, ln_mix, ln_ff2, w_ff2_in, w_ff2_out,
              conv_w_in, conv_kernel, conv_w_out, attn_w_qkv, attn_sinks, attn_w_o, ln_final):
    for i in range(DEPTH):
        x = x + 0.5 * swiglu(rmsnorm(x, ln_ff1[i]), w_ff1_in[i], w_ff1_out[i])
        h = rmsnorm(x, ln_mix[i])
        j = i // N_MIXERS
        if i % N_MIXERS == 0:
            x = x + short_conv_mixer(h, conv_w_in[j], conv_kernel[j], conv_w_out[j])
        else:
            x = x + sliding_window_attention(h, positions, attn_w_qkv[j], attn_sinks[j], attn_w_o[j])
        x = x + 0.5 * swiglu(rmsnorm(x, ln_ff2[i]), w_ff2_in[i], w_ff2_out[i])
    return rmsnorm(x, ln_final)
```

```cpp
#include <hip/hip_runtime.h>
#include <hip/hip_cooperative_groups.h>
#include <cstdio>
#include <cstdint>
#include <cmath>
namespace cg = cooperative_groups;
namespace pg8 {
#define PG8_LAS __attribute__((address_space(3)))
typedef unsigned short bf16_t;
typedef short bf16x8 __attribute__((ext_vector_type(8)));
typedef float f32x4 __attribute__((ext_vector_type(4)));
typedef unsigned u32x4 __attribute__((ext_vector_type(4)));
constexpr int BM = 256, BK = 64, HALF = 128, HTB = HALF * BK * 2  , STAGE_BYTES = 8 * HTB, NXCD = 8, WGM = 8;

__host__ __device__ __forceinline__ int lds_byte(int r, int c) { const int st = (r >> 4) * 2 + (c >> 5), rr = r & 15, cc = c & 31, ob = rr * 64 + cc * 2; return st * 1024 + (ob ^ (((ob >> 9) & 1) << 5)); }
__host__ __device__ __forceinline__ void stage_rc(int b, int& R, int& C) { const int st = b / 1024, sb = b % 1024, swz = sb ^ (((sb >> 9) & 1) << 5); R = (st >> 1) * 16 + swz / 64; C = (st & 1) * 32 + (swz % 64) / 2; }
__host__ __device__ __forceinline__ int perm32(int rho) { const int n = rho >> 4, i = rho & 15; return 8 * (i >> 2) + 4 * n + (i & 3); }

struct Unit { int pm, pn, sw; };
struct Gemm { const bf16_t* A; const bf16_t* Bt; int M, N, K; const bf16_t* A2; const bf16_t* Bt2; };

struct StaticOrder {
    int nM, nN, nwg, G, c;
    __host__ __device__ void init(int M, int N, int G_, int c_) { nM = M / BM; nN = N / BM; nwg = nM * nN; G = G_; c = c_; }
    __host__ __device__ bool next(int i, Unit& u) const {
        const long L = (long)i * G + c; if (L >= nwg) return false;
        int wgid = (int)L; { const int q = nwg / NXCD, r = nwg % NXCD, xcd = wgid % NXCD, off = wgid / NXCD; wgid = (xcd < r ? xcd * (q + 1) : r * (q + 1) + (xcd - r) * q) + off; }
        const int nig = WGM * nN, gid = wgid / nig, fm = gid * WGM, gsz = (nM - fm) < WGM ? (nM - fm) : WGM;
        u.pm = fm + ((wgid % nig) % gsz); u.pn = (wgid % nig) / gsz; u.sw = 0; return true;
    }
    __device__ __forceinline__ void a_ready(const Unit&) const {}
    __device__ __forceinline__ void done(const Unit&) const {}
};
typedef float f32x2 __attribute__((ext_vector_type(2)));
typedef __bf16 bf16x2_t __attribute__((ext_vector_type(2)));
__device__ __forceinline__ unsigned cvt_pk_bf16(float lo, float hi) { const f32x2 v = {lo, hi}; const bf16x2_t b = __builtin_convertvector(v, bf16x2_t); return __builtin_bit_cast(unsigned, b); }
template <class Epi, class Sched, bool ALIGN_EPI = false, bool SP2 = false>
__device__ __forceinline__ void gemm_phase(PG8_LAS unsigned char* lds, const Gemm g, const Sched& S, const Epi& E) {
    int tid_ = threadIdx.x; asm volatile("" : "+v"(tid_));
    const int tid = tid_, wid = __builtin_amdgcn_readfirstlane(tid >> 6), lane = tid & 63, wr = wid >> 2, wc = wid & 3, fr = lane & 15, fq = lane >> 4;
    const int K = g.K, nt = K / BK;
    unsigned voffA[2], voffB[2];
#pragma unroll
    for (int i = 0; i < 2; ++i) { int R, C; stage_rc(tid * 16 + i * 8192, R, C); const int Rb = Epi::PERM ? ((R & ~31) + perm32(R & 31)) : R;
        voffA[i] = (unsigned)(R * K + C) * 2u; voffB[i] = (unsigned)(Rb * K + C) * 2u; }
    const size_t kstep = (size_t)(BK * 2);
    const size_t hstep = (size_t)HALF * K * 2;
    const size_t tstep = 2 * hstep;
    const unsigned ldsw = (unsigned)wid * 1024u;
    const int aoff = lds_byte(wr * 64 + fr, fq * 8), boff = lds_byte(wc * 32 + fr, fq * 8);
#define PG8_SA(b, h) (((b) * 2 + (h)) * HTB)
#define PG8_SB(b, h) ((4 + (b) * 2 + (h)) * HTB)
#define PG8_STAGE(bufoff, gbase, voff) do { _Pragma("unroll") for (int _i = 0; _i < 2; ++_i) \
        __builtin_amdgcn_global_load_lds((const unsigned*)((const char*)(gbase) + (voff)[_i]), (PG8_LAS unsigned*)(lds + (bufoff) + ldsw + _i * 8192), 16, 0, 0); } while (0)
#define PG8_LDA(dst, b, h) do { _Pragma("unroll") for (int m = 0; m < 4; ++m) _Pragma("unroll") for (int k = 0; k < 2; ++k) dst[m][k] = *(const PG8_LAS bf16x8*)(lds + PG8_SA(b, h) + aoff + m * 2048 + k * 1024); } while (0)
#define PG8_LDB(dst, b, h) do { _Pragma("unroll") for (int n = 0; n < 2; ++n) _Pragma("unroll") for (int k = 0; k < 2; ++k) dst[n][k] = *(const PG8_LAS bf16x8*)(lds + PG8_SB(b, h) + boff + n * 2048 + k * 1024); } while (0)
#define PG8_MMA(ai, bj, At, Bt) do { __builtin_amdgcn_s_setprio(1); _Pragma("unroll") for (int m = 0; m < 4; ++m) _Pragma("unroll") for (int n = 0; n < 2; ++n) _Pragma("unroll") for (int k = 0; k < 2; ++k) \
        acc[ai][bj][m][n] = __builtin_amdgcn_mfma_f32_16x16x32_bf16(Bt[n][k], At[m][k], acc[ai][bj][m][n], 0, 0, 0); __builtin_amdgcn_s_setprio(0); } while (0)
#define PG8_WAIT_V(n) asm volatile("s_waitcnt vmcnt(" #n ")" ::: "memory")
#define PG8_WAIT_L(n) asm volatile("s_waitcnt lgkmcnt(" #n ")" ::: "memory")
#define PG8_BAR __builtin_amdgcn_s_barrier()
#define PG8_SCHED __builtin_amdgcn_sched_barrier(0)
    Unit cur, nxt; int ui = 0;
    if (!S.next(0, cur)) return;
    f32x4 acc[2][2][4][2];
#pragma unroll
    for (int a = 0; a < 2; ++a)
#pragma unroll
        for (int b = 0; b < 2; ++b)
#pragma unroll
            for (int m = 0; m < 4; ++m)
#pragma unroll
                for (int n = 0; n < 2; ++n) acc[a][b][m][n] = (f32x4){0.f, 0.f, 0.f, 0.f};
    bf16x8 At[4][2], B0[2][2], B1[2][2];
    const char* cA = (const char*)(cur.sw ? g.A2 : g.A) + (size_t)cur.pm * tstep; const char* cB = (const char*)(cur.sw ? g.Bt2 : g.Bt) + (size_t)cur.pn * tstep;
    S.a_ready(cur);
    if constexpr (SP2) {
        PG8_STAGE(PG8_SB(0, 0), cB, voffB); PG8_STAGE(PG8_SB(0, 1), cB + hstep, voffB); PG8_STAGE(PG8_SA(0, 0), cA, voffA); PG8_STAGE(PG8_SA(0, 1), cA + hstep, voffA);
        if (wr == 1) PG8_BAR;
        PG8_WAIT_V(2); PG8_BAR;
        PG8_STAGE(PG8_SB(1, 0), cB + kstep, voffB); PG8_STAGE(PG8_SA(1, 0), cA + kstep, voffA); PG8_STAGE(PG8_SB(1, 1), cB + hstep + kstep, voffB);
        PG8_WAIT_V(6); PG8_BAR;
    } else {
        PG8_STAGE(PG8_SB(0, 0), cB, voffB); PG8_STAGE(PG8_SA(0, 0), cA, voffA); PG8_STAGE(PG8_SB(0, 1), cB + hstep, voffB); PG8_STAGE(PG8_SA(0, 1), cA + hstep, voffA);
        if (wr == 1) PG8_BAR;
        PG8_WAIT_V(4); PG8_BAR;
        PG8_STAGE(PG8_SB(1, 0), cB + kstep, voffB); PG8_STAGE(PG8_SA(1, 0), cA + kstep, voffA); PG8_STAGE(PG8_SB(1, 1), cB + hstep + kstep, voffB);
        PG8_WAIT_V(6); PG8_BAR;
    }
    for (;;) {
        const bool has_next = S.next(ui + 1, nxt);
        const char* nA = has_next ? (const char*)(nxt.sw ? g.A2 : g.A) + (size_t)nxt.pm * tstep : cA; const char* nB = has_next ? (const char*)(nxt.sw ? g.Bt2 : g.Bt) + (size_t)nxt.pn * tstep : cB;
        for (int t = 0; t < nt; t += 2) {
            if constexpr (Epi::PF_TRIPS > 0) { if (t == nt - 2 * Epi::PF_TRIPS) E.prefetch(cur, tid, lds + STAGE_BYTES + wid * 512); }
            const bool last = (t == nt - 2);
            const char* a1 = cA + (size_t)(t + 1) * kstep;
            const char* a2 = last ? nA : cA + (size_t)(t + 2) * kstep; const char* b2 = last ? nB : cB + (size_t)(t + 2) * kstep;
            const char* a3 = a2 + kstep; const char* b3 = b2 + kstep;
            if (last && has_next) S.a_ready(nxt);
            if constexpr (SP2) {
            PG8_LDB(B0, 0, 0); PG8_LDB(B1, 0, 1); PG8_SCHED; PG8_LDA(At, 0, 0); PG8_STAGE(PG8_SA(1, 1), a1 + hstep, voffA);
            PG8_WAIT_V(8); PG8_WAIT_L(0); PG8_BAR; PG8_MMA(0, 0, At, B0); PG8_MMA(0, 1, At, B1); PG8_BAR; PG8_SCHED;
            PG8_LDA(At, 0, 1); PG8_STAGE(PG8_SB(0, 0), b2, voffB); PG8_STAGE(PG8_SB(0, 1), b2 + hstep, voffB); PG8_STAGE(PG8_SA(0, 0), a2, voffA);
            PG8_WAIT_V(8); PG8_WAIT_L(0); PG8_BAR; PG8_MMA(1, 0, At, B0); PG8_MMA(1, 1, At, B1); PG8_BAR; PG8_SCHED;
            PG8_LDB(B0, 1, 0); PG8_LDB(B1, 1, 1); PG8_SCHED; PG8_LDA(At, 1, 0); PG8_STAGE(PG8_SA(0, 1), a2 + hstep, voffA);
            PG8_WAIT_V(8); PG8_WAIT_L(0); PG8_BAR; PG8_MMA(0, 0, At, B0); PG8_MMA(0, 1, At, B1); PG8_BAR; PG8_SCHED;
            PG8_LDA(At, 1, 1); PG8_STAGE(PG8_SB(1, 0), b3, voffB); PG8_STAGE(PG8_SB(1, 1), b3 + hstep, voffB); PG8_STAGE(PG8_SA(1, 0), a3, voffA);
            PG8_WAIT_V(8); PG8_WAIT_L(0); PG8_BAR; PG8_MMA(1, 0, At, B0); PG8_MMA(1, 1, At, B1); PG8_BAR; PG8_SCHED;
            } else {
            PG8_LDB(B0, 0, 0); PG8_SCHED; PG8_LDA(At, 0, 0); PG8_STAGE(PG8_SA(1, 1), a1 + hstep, voffA);
            PG8_WAIT_L(8); PG8_BAR; PG8_WAIT_L(0); PG8_MMA(0, 0, At, B0); PG8_BAR; PG8_SCHED;
            PG8_LDB(B1, 0, 1); PG8_STAGE(PG8_SB(0, 0), b2, voffB);
            PG8_BAR; PG8_WAIT_L(0); PG8_MMA(0, 1, At, B1); PG8_BAR;
            PG8_LDA(At, 0, 1); PG8_STAGE(PG8_SA(0, 0), a2, voffA);
            PG8_BAR; PG8_WAIT_L(0); PG8_MMA(1, 0, At, B0); PG8_BAR; PG8_SCHED;
            PG8_STAGE(PG8_SB(0, 1), b2 + hstep, voffB);
            PG8_WAIT_V(6); PG8_BAR; PG8_MMA(1, 1, At, B1); PG8_BAR;
            PG8_LDB(B0, 1, 0); PG8_SCHED; PG8_LDA(At, 1, 0); PG8_STAGE(PG8_SA(0, 1), a2 + hstep, voffA);
            PG8_WAIT_L(8); PG8_BAR; PG8_WAIT_L(0); PG8_MMA(0, 0, At, B0); PG8_BAR; PG8_SCHED;
            PG8_LDB(B1, 1, 1); PG8_STAGE(PG8_SB(1, 0), b3, voffB);
            PG8_BAR; PG8_WAIT_L(0); PG8_MMA(0, 1, At, B1); PG8_BAR;
            PG8_LDA(At, 1, 1); PG8_STAGE(PG8_SA(1, 0), a3, voffA);
            PG8_BAR; PG8_WAIT_L(0); PG8_MMA(1, 0, At, B0); PG8_BAR; PG8_SCHED;
            PG8_STAGE(PG8_SB(1, 1), b3 + hstep, voffB);
            PG8_WAIT_V(6); PG8_BAR; PG8_MMA(1, 1, At, B1); PG8_BAR;
            }
        }
        if constexpr (ALIGN_EPI) { if (wr == 0) PG8_BAR; }
        if constexpr (!Epi::AFTER_DRAIN) { E(acc, cur, wr, wc, fr, fq); S.done(cur); }
        if (!has_next) break;
#pragma unroll
        for (int a = 0; a < 2; ++a)
#pragma unroll
            for (int b = 0; b < 2; ++b)
#pragma unroll
                for (int m = 0; m < 4; ++m)
#pragma unroll
                    for (int n = 0; n < 2; ++n) acc[a][b][m][n] = (f32x4){0.f, 0.f, 0.f, 0.f};
        cur = nxt; cA = nA; cB = nB; ++ui;
        if constexpr (ALIGN_EPI) { if (wr == 1) PG8_BAR; }
    }
    PG8_WAIT_V(0);
    if constexpr (!ALIGN_EPI) { if (wr == 0) PG8_BAR; }
    PG8_BAR;
    if constexpr (Epi::AFTER_DRAIN) { E.fused(acc, cur, wr, wc, fr, fq, lds, wid, lane); S.done(cur); }
#undef PG8_SA
#undef PG8_SB
#undef PG8_STAGE
#undef PG8_LDA
#undef PG8_LDB
#undef PG8_MMA
#undef PG8_WAIT_V
#undef PG8_WAIT_L
#undef PG8_BAR
#undef PG8_SCHED
}
}
namespace pg8 {
constexpr float RMS_EPS_F = 1e-6f;
constexpr float LOG2E_F = 1.4426950408889634f;
constexpr float QSCALE_F = 0.125f * 1.4426950408889634f;
typedef float u64_t;
__device__ __forceinline__ float rstd_row(const u64_t* ssp, int row) {
    const f32x4* p = (const f32x4*)(ssp + (size_t)row * 16);
    const f32x4 a = p[0], b = p[1], c = p[2], d = p[3];
    const f32x4 s = (a + b) + (c + d);
    const float t = (s[0] + s[1]) + (s[2] + s[3]);
    return __builtin_amdgcn_rsqf(t * (1.0f / 1024.0f) + RMS_EPS_F);
}
struct RstdTab {
    PG8_LAS float* tab; mutable int cpm;
    __device__ __forceinline__ void refresh(const u64_t* ssq, int pm, int wr, int fr, int fq) const {
        if (pm != cpm) {
            cpm = pm;
            const int lane = fr + 16 * fq;
#pragma unroll
            for (int h = 0; h < 2; ++h) { const int idx = lane + 64 * h, am = idx >> 4, f = idx & 15;
                tab[idx] = rstd_row(ssq, pm * BM + (am >> 2) * HALF + wr * 64 + (am & 3) * 16 + f); }
        }
    }
    __device__ __forceinline__ float get(int ai, int m, int fr) const { return tab[(ai * 4 + m) * 16 + fr]; }
};
__device__ __forceinline__ u32x4 pack8(const float (&o)[8]) {
    u32x4 w; w.x = cvt_pk_bf16(o[0], o[1]); w.y = cvt_pk_bf16(o[2], o[3]); w.z = cvt_pk_bf16(o[4], o[5]); w.w = cvt_pk_bf16(o[6], o[7]); return w;
}
struct EpiSwiGLU {
    static constexpr bool PERM = true, AFTER_DRAIN = false; static constexpr int PF_TRIPS = 0;
    bf16_t* O; const u64_t* ssp; int ldo; RstdTab rt;
    __device__ __forceinline__ void operator()(const f32x4 (&acc)[2][2][4][2], const Unit& u, int wr, int wc, int fr, int fq) const {
        asm volatile("" : "+v"(fr), "+v"(fq));
        const int row0 = u.pm * BM + wr * 64 + fr, col0 = u.pn * 128 + wc * 32 + 8 * fq;
        rt.refresh(ssp, u.pm, wr, fr, fq);
#pragma unroll
        for (int ai = 0; ai < 2; ++ai)
#pragma unroll
            for (int m = 0; m < 4; ++m) {
                const int row = row0 + ai * HALF + m * 16;
                const float rs = rt.get(ai, m, fr), rsl = rs * -LOG2E_F, irs2 = __builtin_amdgcn_rcpf(rs * rs);
                float o[8];
#pragma unroll
                for (int n = 0; n < 2; ++n) {
                    const f32x4 a = acc[ai][0][m][n], b = acc[ai][1][m][n];
                    const f32x4 t = a * rsl, ab = a * b;
                    f32x4 e; e[0] = __builtin_amdgcn_exp2f(t[0]); e[1] = __builtin_amdgcn_exp2f(t[1]); e[2] = __builtin_amdgcn_exp2f(t[2]); e[3] = __builtin_amdgcn_exp2f(t[3]);
                    const f32x4 d = e * irs2 + irs2;
                    f32x4 r; r[0] = __builtin_amdgcn_rcpf(d[0]); r[1] = __builtin_amdgcn_rcpf(d[1]); r[2] = __builtin_amdgcn_rcpf(d[2]); r[3] = __builtin_amdgcn_rcpf(d[3]);
                    const f32x4 q = ab * r;
                    o[n * 4 + 0] = q[0]; o[n * 4 + 1] = q[1]; o[n * 4 + 2] = q[2]; o[n * 4 + 3] = q[3];
                }
                { const u32x4 pk_ = pack8(o); *(u32x4*)(O + (size_t)row * ldo + col0) = pk_;
#ifdef PROBE_ST2
                  *(volatile u32x4*)(O + (size_t)row * ldo + col0) = pk_;
#endif
                }
            }
    }
};
__device__ __forceinline__ void unpack8f(const u32x4 w, float (&f)[8]) {
    f[0] = __uint_as_float(w.x << 16); f[1] = __uint_as_float(w.x & 0xffff0000u); f[2] = __uint_as_float(w.y << 16); f[3] = __uint_as_float(w.y & 0xffff0000u);
    f[4] = __uint_as_float(w.z << 16); f[5] = __uint_as_float(w.z & 0xffff0000u); f[6] = __uint_as_float(w.w << 16); f[7] = __uint_as_float(w.w & 0xffff0000u);
}
struct EpiResid {
    static constexpr bool PERM = true, AFTER_DRAIN = false; static constexpr int PF_TRIPS = 4;
    bf16_t* xb; u64_t* ssq; float scale;
    __device__ __forceinline__ void prefetch(const Unit& u, int tid, PG8_LAS unsigned char* scratch) const {
        const bf16_t* sb = xb + ((size_t)(u.pm * BM) * 1024 + u.pn * BM);
        const unsigned voff = (unsigned)(((tid >> 2) * 1024 + (tid & 3) * 64) * 2);
        const unsigned l0 = (unsigned)__builtin_amdgcn_readfirstlane((int)(unsigned)(uintptr_t)scratch);
        const bf16_t* sb2 = sb + (size_t)128 * 1024;
        unsigned keep;
        asm volatile("s_mov_b32 %0, m0\n\ts_mov_b32 m0, %3\n\ts_nop 0\n\tglobal_load_lds_dword %1, %2\n\ts_mov_b32 m0, %5\n\ts_nop 0\n\tglobal_load_lds_dword %1, %4\n\ts_mov_b32 m0, %0"
                     : "=&s"(keep) : "v"(voff), "s"(sb), "s"(l0), "s"(sb2), "s"(l0 + 256u) : "memory");
    }
    __device__ __forceinline__ void operator()(const f32x4 (&acc)[2][2][4][2], const Unit& u, int wr, int wc, int fr, int fq) const {
        asm volatile("" : "+v"(fr), "+v"(fq));
        const int row0 = u.pm * BM + wr * 64 + fr, col0 = u.pn * BM + wc * 32 + 8 * fq;
#pragma unroll
        for (int ai = 0; ai < 2; ++ai) {
            u32x4 bx[4][2];
#pragma unroll
            for (int m = 0; m < 4; ++m)
#pragma unroll
                for (int bj = 0; bj < 2; ++bj) bx[m][bj] = *(const u32x4*)(xb + (size_t)(row0 + ai * HALF + m * 16) * 1024 + col0 + bj * HALF);
#pragma unroll
            for (int m = 0; m < 4; ++m) {
                const int row = row0 + ai * HALF + m * 16;
                float ss = 0.f;
#pragma unroll
                for (int bj = 0; bj < 2; ++bj) {
                    const size_t off = (size_t)row * 1024 + col0 + bj * HALF;
                    float b[8], v[8]; unpack8f(bx[m][bj], b);
#pragma unroll
                    for (int n = 0; n < 2; ++n)
#pragma unroll
                        for (int j = 0; j < 4; ++j) { const float t = b[n * 4 + j] + acc[ai][bj][m][n][j] * scale; v[n * 4 + j] = t; ss += t * t; }
                    *(u32x4*)(xb + off) = pack8(v);
                }
                ss += __shfl_xor(ss, 16); ss += __shfl_xor(ss, 32);
                if (fq == 0) ssq[(size_t)row * 16 + u.pn * 4 + wc] = ss;
            }
            asm volatile("" ::: "memory");
        }
    }
};
struct EpiConvIn {
    static constexpr bool PERM = true, AFTER_DRAIN = false; static constexpr int PF_TRIPS = 0;
    bf16_t* Z; bf16_t* Bg; const u64_t* ssp; RstdTab rt;
    __device__ __forceinline__ void operator()(const f32x4 (&acc)[2][2][4][2], const Unit& u, int wr, int wc, int fr, int fq) const {
        asm volatile("" : "+v"(fr), "+v"(fq));
        const int row0 = u.pm * BM + wr * 64 + fr;
        rt.refresh(ssp, u.pm, wr, fr, fq);
        if (u.pn < 8) {
            const int col0 = u.pn * 128 + wc * 32 + 8 * fq;
#pragma unroll
            for (int ai = 0; ai < 2; ++ai)
#pragma unroll
                for (int m = 0; m < 4; ++m) {
                    const int row = row0 + ai * HALF + m * 16;
                    const float rs = rt.get(ai, m, fr), rs2 = rs * rs;
                    float o[8];
#pragma unroll
                    for (int n = 0; n < 2; ++n)
#pragma unroll
                        for (int j = 0; j < 4; ++j) o[n * 4 + j] = acc[ai][0][m][n][j] * acc[ai][1][m][n][j] * rs2;
                    *(u32x4*)(Z + (size_t)row * 1024 + col0) = pack8(o);
                }
        } else {
            const int col0 = (u.pn - 8) * BM + wc * 32 + 8 * fq;
#pragma unroll
            for (int ai = 0; ai < 2; ++ai)
#pragma unroll
                for (int m = 0; m < 4; ++m) {
                    const int row = row0 + ai * HALF + m * 16;
                    const float rs = rt.get(ai, m, fr);
#pragma unroll
                    for (int bj = 0; bj < 2; ++bj) {
                        float o[8];
#pragma unroll
                        for (int n = 0; n < 2; ++n)
#pragma unroll
                            for (int j = 0; j < 4; ++j) o[n * 4 + j] = acc[ai][bj][m][n][j] * rs;
                        *(u32x4*)(Bg + (size_t)row * 1024 + col0 + bj * HALF) = pack8(o);
                    }
                }
        }
    }
};
struct EpiQKV {
    static constexpr bool PERM = true, AFTER_DRAIN = false; static constexpr int PF_TRIPS = 0;
    bf16_t* Q; bf16_t* Kb; bf16_t* Vt; const u64_t* ssp; const float* cs; int seq; RstdTab rt;
    __device__ __forceinline__ void operator()(const f32x4 (&acc)[2][2][4][2], const Unit& u, int wr, int wc, int fr, int fq) const {
        asm volatile("" : "+v"(fr), "+v"(fq));
        const int row0 = u.pm * BM + wr * 64 + fr;
        if (!u.sw) {
            const bool isq = u.pn < 4;
            rt.refresh(ssp, u.pm, wr, fr, fq);
            f32x4 tn[4];
            { const f32x4* cp = (const f32x4*)(cs + (size_t)row0 * 64 + 16 * fq); tn[0] = cp[0]; tn[1] = cp[1]; tn[2] = cp[2]; tn[3] = cp[3]; }
#pragma unroll
            for (int it = 0; it < 8; ++it) {
                const int ai = it >> 2, m = it & 3;
                const int row = row0 + ai * HALF + m * 16;
                float rs = rt.get(ai, m, fr); if (isq) rs *= QSCALE_F;
                const f32x4 t0 = tn[0], t1 = tn[1], t2 = tn[2], t3 = tn[3];
                if (it < 7) { const int nrow = row0 + ((it + 1) >> 2) * HALF + ((it + 1) & 3) * 16; const f32x4* cp = (const f32x4*)(cs + (size_t)nrow * 64 + 16 * fq); tn[0] = cp[0]; tn[1] = cp[1]; tn[2] = cp[2]; tn[3] = cp[3]; }
                const float cc[8] = {t0[0], t0[2], t1[0], t1[2], t2[0], t2[2], t3[0], t3[2]};
                const float sn[8] = {t0[1], t0[3], t1[1], t1[3], t2[1], t2[3], t3[1], t3[3]};
                float o1[8], o2[8];
#pragma unroll
                for (int n = 0; n < 2; ++n)
#pragma unroll
                    for (int j = 0; j < 4; ++j) {
                        const int k = n * 4 + j;
                        const float x1 = acc[ai][0][m][n][j] * rs, x2 = acc[ai][1][m][n][j] * rs;
                        o1[k] = x1 * cc[k] - x2 * sn[k]; o2[k] = x2 * cc[k] + x1 * sn[k];
                    }
                bf16_t* dst;
                if (isq) dst = Q + (size_t)row * 1024 + u.pn * 256 + wc * 64 + 8 * fq;
                else { const int b = row / seq, t = row - b * seq; dst = Kb + ((size_t)(b * 4 + wc) * seq + t) * 64 + 8 * fq; }
                *(u32x4*)dst = pack8(o1); *(u32x4*)(dst + 32) = pack8(o2);
            }
        } else {
#pragma unroll
            for (int bj = 0; bj < 2; ++bj) {
                const int tok0 = u.pn * BM + bj * HALF + wc * 32 + 8 * fq, b = tok0 / seq, t = tok0 - b * seq;
                float rs[8];
#pragma unroll
                for (int k = 0; k < 8; ++k) { rs[k] = rstd_row(ssp, tok0 + k); if (k & 1) asm volatile("" ::: "memory"); }
#pragma unroll
                for (int ai = 0; ai < 2; ++ai)
#pragma unroll
                    for (int m = 0; m < 4; ++m) {
                        const int vc = ai * HALF + wr * 64 + m * 16 + fr;
                        float o[8];
#pragma unroll
                        for (int n = 0; n < 2; ++n)
#pragma unroll
                            for (int j = 0; j < 4; ++j) o[n * 4 + j] = acc[ai][bj][m][n][j] * rs[n * 4 + j];
                        *(u32x4*)(Vt + ((size_t)(b * 256 + vc)) * seq + t) = pack8(o);
                    }
                asm volatile("" ::: "memory");
            }
        }
    }
};
struct QkvOrder {
    StaticOrder so; int G, c;
    __host__ __device__ void init(int M, int G_, int c_) { so.init(M, 1280, G_, c_); G = G_; c = c_; }
    __host__ __device__ bool next(int i, Unit& u) const {
        const long L = (long)i * G + c; if (L < so.nwg) return so.next(i, u);
        const int r = (int)(L - so.nwg); if (r >= so.nM) return false;
        u.pm = 0; u.pn = r; u.sw = 1; return true;
    }
    __device__ __forceinline__ void a_ready(const Unit&) const {}
    __device__ __forceinline__ void done(const Unit&) const {}
};
}
constexpr int BATCH = 2, SEQ = 16384, D = 1024, FF = 2816, DEPTH = 4, M = BATCH * SEQ;
constexpr int NQKV = 1536, NCIN = 3072, NFFIN = 2 * FF;
constexpr int NWAVES = 8, NTHREADS = NWAVES * 64;
constexpr int LDS_BYTES = 147456;
constexpr size_t MiB = 1u << 20;
constexpr size_t SZ_WFFIN = (size_t)NFFIN * D * 2, SZ_WFFOUT = (size_t)D * FF * 2, SZ_WCIN = (size_t)NCIN * D * 2, SZ_WSQ = (size_t)D * D * 2, SZ_WQKV = (size_t)NQKV * D * 2;
constexpr size_t WS_WFFIN = 0;
constexpr size_t WS_WFFOUT = WS_WFFIN + 8 * SZ_WFFIN;
constexpr size_t WS_WCIN = WS_WFFOUT + 8 * SZ_WFFOUT;
constexpr size_t WS_WCOUT = WS_WCIN + 2 * SZ_WCIN;
constexpr size_t WS_WQKV = WS_WCOUT + 2 * SZ_WSQ;
constexpr size_t WS_WO = WS_WQKV + 2 * SZ_WQKV;
constexpr size_t WS_XB = WS_WO + 2 * SZ_WSQ;
constexpr int NSSQ = 3 * DEPTH + 1;
constexpr size_t WS_SS = WS_XB + (size_t)M * D * 2;
constexpr size_t WS_CS = WS_SS + (size_t)NSSQ * M * 8;
constexpr size_t WS_BIG = WS_CS + (size_t)M * 64 * 4;
constexpr size_t WS_CTL = WS_BIG + (size_t)M * FF * 2;
constexpr size_t WS_END = WS_CTL + 16384;
static_assert(WS_END <= 440 * MiB, "workspace map");

typedef pg8::bf16_t bf16_t;
typedef pg8::f32x4 f32x4;
typedef pg8::u32x4 u32x4;
typedef pg8::bf16x8 bf16x8;
typedef float f32x16 __attribute__((ext_vector_type(16)));
#define LAS __attribute__((address_space(3)))

struct Params {
    const float* x; const int* pos; const float* ln_ff1; const float* w_ff1_in; const float* w_ff1_out; const float* ln_mix; const float* ln_ff2;
    const float* w_ff2_in; const float* w_ff2_out; const float* conv_w_in; const float* conv_kernel; const float* conv_w_out;
    const float* attn_w_qkv; const float* attn_sinks; const float* attn_w_o; const float* ln_final;
    float* out; unsigned char* ws;
};

static __device__ const float INV_FREQ[32] = {
    1.000000000e+00f, 7.498942018e-01f, 5.623413324e-01f, 4.216965139e-01f, 3.162277639e-01f, 2.371373773e-01f, 1.778279394e-01f, 1.333521456e-01f,
    1.000000015e-01f, 7.498942316e-02f, 5.623413250e-02f, 4.216964915e-02f, 3.162277490e-02f, 2.371373773e-02f, 1.778279431e-02f, 1.333521400e-02f,
    9.999999776e-03f, 7.498942316e-03f, 5.623413250e-03f, 4.216964822e-03f, 3.162277630e-03f, 2.371373819e-03f, 1.778279431e-03f, 1.333521446e-03f,
    1.000000047e-03f, 7.498941850e-04f, 5.623413017e-04f, 4.216965172e-04f, 3.162277571e-04f, 2.371373703e-04f, 1.778279402e-04f, 1.333521504e-04f};

__device__ __forceinline__ float wave_sum(float v) {
#pragma unroll
    for (int o = 1; o < 64; o <<= 1) v += __shfl_xor(v, o);
    return v;
}
__device__ __forceinline__ void transpose_item(const float* W, int K, int N, const float* gain, bf16_t* WT, int k0, int n0, int drowA, int drowB, LAS float* scr, int lane) {
    f32x4 v[16];
#pragma unroll
    for (int i = 0; i < 16; ++i) v[i] = *(const f32x4*)(W + (size_t)(k0 + 4 * i + (lane >> 4)) * N + n0 + 4 * (lane & 15));
    if (gain) {
#pragma unroll
        for (int i = 0; i < 16; ++i) v[i] = v[i] * gain[k0 + 4 * i + (lane >> 4)];
    }
#pragma unroll
    for (int i = 0; i < 16; ++i) { LAS float* d = scr + (4 * i + (lane >> 4)) * 65 + 4 * (lane & 15); d[0] = v[i][0]; d[1] = v[i][1]; d[2] = v[i][2]; d[3] = v[i][3]; }
    asm volatile("s_waitcnt lgkmcnt(0)" ::: "memory");
    const int c = lane & 7;
#pragma unroll
    for (int j = 0; j < 8; ++j) { const int n = (lane >> 3) + 8 * j; const LAS float* s = scr + (8 * c) * 65 + n;
        u32x4 o; o.x = pg8::cvt_pk_bf16(s[0 * 65], s[1 * 65]); o.y = pg8::cvt_pk_bf16(s[2 * 65], s[3 * 65]); o.z = pg8::cvt_pk_bf16(s[4 * 65], s[5 * 65]); o.w = pg8::cvt_pk_bf16(s[6 * 65], s[7 * 65]);
        const int drow = j < 4 ? drowA + n : drowB + n - 32;
        *(u32x4*)(WT + (size_t)drow * K + k0 + 8 * c) = o; }
    asm volatile("s_waitcnt lgkmcnt(0)" ::: "memory");
}
__device__ __forceinline__ int bt_row(int type, int s) {
    if (type == 1) { const int up = s >= FF, f = up ? s - FF : s; return 256 * (f >> 7) + (up ? 128 : 0) + (f & 127); }
    if (type == 2) { if (s < 1024) return 2048 + s; const int uu = s >= 2048, ch = s - (uu ? 2048 : 1024); return 256 * (ch >> 7) + (uu ? 128 : 0) + (ch & 127); }
    if (type == 3) { if (s >= 1280) return s; const int pn = s >> 8, hh = (s & 255) >> 6, bj = (s & 63) >> 5; return 256 * pn + 128 * bj + 32 * hh; }
    return s;
}
constexpr int IT_FFIN = (D / 64) * (NFFIN / 64), IT_FFOUT = (FF / 64) * (D / 64), IT_CIN = (D / 64) * (NCIN / 64), IT_SQ = (D / 64) * (D / 64), IT_QKV = (D / 64) * (NQKV / 64);
constexpr int IT_LAYER = 2 * (IT_FFIN + IT_FFOUT), IT_FFN_ALL = DEPTH * IT_LAYER, IT_CONV = IT_CIN + IT_SQ, IT_ATTN = IT_QKV + IT_SQ;
constexpr int IT_ALL = IT_FFN_ALL + 2 * IT_CONV + 2 * IT_ATTN;

__device__ __forceinline__ void prologue(const Params& P, LAS unsigned char* lds, int wave, int lane, int G) {
    asm volatile("" : "+v"(lane));
    unsigned char* ws = P.ws;
    LAS float* scr = (LAS float*)(lds + wave * 16640);
    const int gw = blockIdx.x * NWAVES + wave, NGW = G * NWAVES;
    for (int it = gw; it < IT_ALL; it += NGW) {
        int r = it; const float* W; const float* gain = nullptr; bf16_t* WT; int K, N, type = 0;
        if (r < IT_FFN_ALL) {
            const int l = r / IT_LAYER; r -= l * IT_LAYER; const int which = r >= (IT_FFIN + IT_FFOUT); if (which) r -= IT_FFIN + IT_FFOUT;
            if (r < IT_FFIN) { W = (which ? P.w_ff2_in : P.w_ff1_in) + (size_t)l * D * NFFIN; gain = (which ? P.ln_ff2 : P.ln_ff1) + l * D; WT = (bf16_t*)(ws + WS_WFFIN + (size_t)(l * 2 + which) * SZ_WFFIN); K = D; N = NFFIN; type = 1; }
            else { r -= IT_FFIN; W = (which ? P.w_ff2_out : P.w_ff1_out) + (size_t)l * FF * D; WT = (bf16_t*)(ws + WS_WFFOUT + (size_t)(l * 2 + which) * SZ_WFFOUT); K = FF; N = D; }
        } else if (r < IT_FFN_ALL + 2 * IT_CONV) {
            r -= IT_FFN_ALL; const int j = r / IT_CONV; r -= j * IT_CONV;
            if (r < IT_CIN) { W = P.conv_w_in + (size_t)j * D * NCIN; gain = P.ln_mix + (2 * j) * D; WT = (bf16_t*)(ws + WS_WCIN + (size_t)j * SZ_WCIN); K = D; N = NCIN; type = 2; }
            else { r -= IT_CIN; W = P.conv_w_out + (size_t)j * D * D; WT = (bf16_t*)(ws + WS_WCOUT + (size_t)j * SZ_WSQ); K = D; N = D; }
        } else {
            r -= IT_FFN_ALL + 2 * IT_CONV; const int j = r / IT_ATTN; r -= j * IT_ATTN;
            if (r < IT_QKV) { W = P.attn_w_qkv + (size_t)j * D * NQKV; gain = P.ln_mix + (2 * j + 1) * D; WT = (bf16_t*)(ws + WS_WQKV + (size_t)j * SZ_WQKV); K = D; N = NQKV; type = 3; }
            else { r -= IT_QKV; W = P.attn_w_o + (size_t)j * D * D; WT = (bf16_t*)(ws + WS_WO + (size_t)j * SZ_WSQ); K = D; N = D; }
        }
        const int nblk = N / 64, kb = r / nblk, nb = r - kb * nblk;
        transpose_item(W, K, N, gain, WT, 64 * kb, 64 * nb, bt_row(type, 64 * nb), bt_row(type, 64 * nb + 32), scr, lane);
    }
    bf16_t* XB = (bf16_t*)(ws + WS_XB); pg8::u64_t* SS = (pg8::u64_t*)(ws + WS_SS);
    for (int row = gw; row < M; row += 2 * NGW) {
        f32x4 v[2][4];
#pragma unroll
        for (int q = 0; q < 2; ++q)
#pragma unroll
            for (int j = 0; j < 4; ++j) v[q][j] = (row + q * NGW < M) ? ((const f32x4*)(P.x + (size_t)(row + q * NGW) * D) + lane)[64 * j] : (f32x4){0.f, 0.f, 0.f, 0.f};
#pragma unroll
        for (int q = 0; q < 2; ++q) {
            const int r = row + q * NGW; if (r >= M) break;
            unsigned long long* o8 = (unsigned long long*)(XB + (size_t)r * D) + lane;
            float s = 0.f;
#pragma unroll
            for (int j = 0; j < 4; ++j) { const f32x4 w = v[q][j]; s += (w[0] * w[0] + w[1] * w[1]) + (w[2] * w[2] + w[3] * w[3]);
                o8[64 * j] = (unsigned long long)pg8::cvt_pk_bf16(w[0], w[1]) | ((unsigned long long)pg8::cvt_pk_bf16(w[2], w[3]) << 32); }
            s = wave_sum(s);
            if (lane < 16) SS[(size_t)r * 16 + lane] = lane == 0 ? s : 0.f;
        }
    }
    float* CS = (float*)(ws + WS_CS);
    for (int e = gw * 64 + lane; e < M * 32; e += NGW * 64) {
        const int row = e >> 5, i = e & 31;
        const float angf = (float)P.pos[row] * INV_FREQ[i];
        const double a = (double)angf;
        const double kq = __builtin_rint(a * 0.63661977236758134308);
        const double rr = __builtin_fma(-kq, 1.57079632679489661923, a) - kq * 6.123233995736766e-17;
        const double r2 = rr * rr;
        const double sn = rr * (1.0 - r2 / 6.0 * (1.0 - r2 / 20.0 * (1.0 - r2 / 42.0 * (1.0 - r2 / 72.0 * (1.0 - r2 / 110.0 * (1.0 - r2 / 156.0))))));
        const double cn = 1.0 - r2 / 2.0 * (1.0 - r2 / 12.0 * (1.0 - r2 / 30.0 * (1.0 - r2 / 56.0 * (1.0 - r2 / 90.0 * (1.0 - r2 / 132.0 * (1.0 - r2 / 182.0))))));
        const int q = ((int)kq) & 3;
        const double c = (q == 0) ? cn : (q == 1) ? -sn : (q == 2) ? -cn : sn;
        const double s = (q == 0) ? sn : (q == 1) ? cn : (q == 2) ? -sn : -cn;
        *(pg8::f32x2*)(CS + (size_t)e * 2) = (pg8::f32x2){(float)c, (float)s};
    }
}
__device__ __forceinline__ void unpack8(const u32x4 w, float (&f)[8]) {
    f[0] = __uint_as_float(w.x << 16); f[1] = __uint_as_float(w.x & 0xffff0000u); f[2] = __uint_as_float(w.y << 16); f[3] = __uint_as_float(w.y & 0xffff0000u);
    f[4] = __uint_as_float(w.z << 16); f[5] = __uint_as_float(w.z & 0xffff0000u); f[6] = __uint_as_float(w.w << 16); f[7] = __uint_as_float(w.w & 0xffff0000u);
}
__device__ __forceinline__ void conv_phase(const bf16_t* Z, bf16_t* Bg, const float* ck, int tid, int G) {
    asm volatile("" : "+v"(tid));
    const int cg8 = tid & 127, tr = tid >> 7;
    float k0[8], k1[8], k2[8];
    { const f32x4* p = (const f32x4*)(ck + 8 * cg8); const f32x4 a = p[0], b = p[1]; k0[0] = a[0]; k0[1] = a[1]; k0[2] = a[2]; k0[3] = a[3]; k0[4] = b[0]; k0[5] = b[1]; k0[6] = b[2]; k0[7] = b[3]; }
    { const f32x4* p = (const f32x4*)(ck + D + 8 * cg8); const f32x4 a = p[0], b = p[1]; k1[0] = a[0]; k1[1] = a[1]; k1[2] = a[2]; k1[3] = a[3]; k1[4] = b[0]; k1[5] = b[1]; k1[6] = b[2]; k1[7] = b[3]; }
    { const f32x4* p = (const f32x4*)(ck + 2 * D + 8 * cg8); const f32x4 a = p[0], b = p[1]; k2[0] = a[0]; k2[1] = a[1]; k2[2] = a[2]; k2[3] = a[3]; k2[4] = b[0]; k2[5] = b[1]; k2[6] = b[2]; k2[7] = b[3]; }
    for (int c = blockIdx.x; c < M / 64; c += G) {
        const int t0 = c * 64 + tr * 16;
        float z2[8], z1[8];
        if ((t0 & (SEQ - 1)) == 0) {
#pragma unroll
            for (int i = 0; i < 8; ++i) { z2[i] = 0.f; z1[i] = 0.f; }
        } else {
            unpack8(*(const u32x4*)(Z + (size_t)(t0 - 2) * D + 8 * cg8), z2); unpack8(*(const u32x4*)(Z + (size_t)(t0 - 1) * D + 8 * cg8), z1);
        }
#pragma unroll 1
        for (int tb = 0; tb < 16; tb += 8) {
            u32x4 zr[8], br[8];
#pragma unroll
            for (int tt = 0; tt < 8; ++tt) { const size_t off = (size_t)(t0 + tb + tt) * D + 8 * cg8; zr[tt] = *(const u32x4*)(Z + off); br[tt] = *(const u32x4*)(Bg + off); }
#pragma unroll
            for (int tt = 0; tt < 8; ++tt) {
                float zc[8], bg[8], y[8];
                unpack8(zr[tt], zc); unpack8(br[tt], bg);
#pragma unroll
                for (int i = 0; i < 8; ++i) { y[i] = bg[i] * (k0[i] * z2[i] + k1[i] * z1[i] + k2[i] * zc[i]); z2[i] = z1[i]; z1[i] = zc[i]; }
                *(u32x4*)(Bg + (size_t)(t0 + tb + tt) * D + 8 * cg8) = pg8::pack8(y);
            }
        }
    }
}
constexpr int AT_KP = 72, AT_VP = 264, AT_VOFF = 256 * AT_KP * 2;
__device__ __forceinline__ void attn_item(int b, int h, int qc, int qtl, const bf16_t* Q, LAS const unsigned char* lds, const float* sinks, bf16_t* O, int lane) {
    const int ql = lane & 31, hi = lane >> 5, q0 = qc * 128 + qtl * 32;
    const bf16_t* Qrow = Q + (size_t)(b * SEQ + q0 + ql) * D + h * 64 + hi * 8;
    bf16x8 qf[4];
#pragma unroll
    for (int d0 = 0; d0 < 4; ++d0) qf[d0] = *(const bf16x8*)(Qrow + d0 * 16);
    const int pil = (ql & ~12) | ((ql & 4) << 1) | ((ql & 8) >> 1);
    LAS const unsigned char* kb = lds + ((qtl * 32 + pil) * AT_KP + hi * 8) * 2;
    f32x16 s[5];
#pragma unroll
    for (int i = 0; i < 5; ++i) {
#pragma unroll
        for (int r = 0; r < 16; ++r) s[i][r] = 0.f;
#pragma unroll
        for (int d0 = 0; d0 < 4; ++d0) { const bf16x8 kf = *(LAS const bf16x8*)(kb + (i * 32 * AT_KP + d0 * 16) * 2); s[i] = __builtin_amdgcn_mfma_f32_32x32x16_bf16(kf, qf[d0], s[i], 0, 0, 0); }
    }
    const float sk = sinks[h] * pg8::LOG2E_F;
    float mx = sk;
#pragma unroll
    for (int i = 0; i < 5; ++i) {
        const bool tv = (qc > 0 || qtl + i >= 4);
#pragma unroll
        for (int r = 0; r < 16; ++r) {
            const int off = 16 * (r >> 3) + 8 * hi + (r & 7);
            bool ok = tv; if (i == 0) ok = ok && (off > ql); if (i == 4) ok = ok && (off <= ql);
            const float v = ok ? s[i][r] : -INFINITY; s[i][r] = v; mx = fmaxf(mx, v);
        }
    }
    mx = fmaxf(mx, __shfl_xor(mx, 32));
    float l = 0.f;
#pragma unroll
    for (int i = 0; i < 5; ++i)
#pragma unroll
        for (int r = 0; r < 16; ++r) { const float p = __builtin_amdgcn_exp2f(s[i][r] - mx); s[i][r] = p; l += p; }
    l += __shfl_xor(l, 32); l += __builtin_amdgcn_exp2f(sk - mx);
    const float rl = 1.0f / l;
    f32x16 o[2], o2[2];
#pragma unroll
    for (int r = 0; r < 16; ++r) { o[0][r] = 0.f; o[1][r] = 0.f; o2[0][r] = 0.f; o2[1][r] = 0.f; }
    LAS const unsigned char* vb = lds + AT_VOFF + (ql * AT_VP + qtl * 32 + hi * 8) * 2;
#pragma unroll
    for (int i = 0; i < 5; ++i) {
#pragma unroll
        for (int sl = 0; sl < 2; ++sl) {
            u32x4 pw; pw.x = pg8::cvt_pk_bf16(s[i][8 * sl + 0], s[i][8 * sl + 1]); pw.y = pg8::cvt_pk_bf16(s[i][8 * sl + 2], s[i][8 * sl + 3]);
            pw.z = pg8::cvt_pk_bf16(s[i][8 * sl + 4], s[i][8 * sl + 5]); pw.w = pg8::cvt_pk_bf16(s[i][8 * sl + 6], s[i][8 * sl + 7]);
            const bf16x8 pf = __builtin_bit_cast(bf16x8, pw);
#pragma unroll
            for (int dt = 0; dt < 2; ++dt) { const bf16x8 vf = *(LAS const bf16x8*)(vb + (dt * 32 * AT_VP + i * 32 + 16 * sl) * 2);
                if (sl == 0) o[dt] = __builtin_amdgcn_mfma_f32_32x32x16_bf16(vf, pf, o[dt], 0, 0, 0); else o2[dt] = __builtin_amdgcn_mfma_f32_32x32x16_bf16(vf, pf, o2[dt], 0, 0, 0); }
        }
    }
#pragma unroll
    for (int r = 0; r < 16; ++r) { o[0][r] += o2[0][r]; o[1][r] += o2[1][r]; }
    bf16_t* Orow = O + (size_t)(b * SEQ + q0 + ql) * D + h * 64 + 4 * hi;
#pragma unroll
    for (int dt = 0; dt < 2; ++dt)
#pragma unroll
        for (int rr = 0; rr < 4; ++rr) {
            const unsigned lo = pg8::cvt_pk_bf16(o[dt][4 * rr + 0] * rl, o[dt][4 * rr + 1] * rl), hi2 = pg8::cvt_pk_bf16(o[dt][4 * rr + 2] * rl, o[dt][4 * rr + 3] * rl);
            *(unsigned long long*)(Orow + 32 * dt + 8 * rr) = (unsigned long long)lo | ((unsigned long long)hi2 << 32);
        }
}
constexpr int AT_NCH = BATCH * 4 * (SEQ / 128);
__device__ __forceinline__ void attn_load(int c, const bf16_t* Kb, const bf16_t* Vt, int tid, u32x4 (&kreg)[4], u32x4 (&vreg)[4]) {
    const int bk = c / (SEQ / 128), qc = c - bk * (SEQ / 128), kb0 = qc * 128 - 128;
    const bf16_t* kg = Kb + ((size_t)bk * SEQ + kb0) * 64;
    const bf16_t* vg = Vt + (size_t)bk * 64 * SEQ + kb0;
#pragma unroll
    for (int i = 0; i < 4; ++i) {
        const int p = tid + 512 * i;
        if (qc > 0 || (p >> 3) >= 128) kreg[i] = *(const u32x4*)(kg + (size_t)p * 8); else kreg[i] = (u32x4){0u, 0u, 0u, 0u};
        if (qc > 0 || (p & 31) >= 16) vreg[i] = *(const u32x4*)(vg + (size_t)(p >> 5) * SEQ + (p & 31) * 8); else vreg[i] = (u32x4){0u, 0u, 0u, 0u};
    }
}
__device__ __forceinline__ void attn_phase(const bf16_t* Q, const bf16_t* Kb, const bf16_t* Vt, const float* sinks, bf16_t* O, LAS unsigned char* lds, int tid, int wave, int lane, int G) {
    asm volatile("" : "+v"(lane), "+v"(tid));
    u32x4 kreg[4], vreg[4];
    int c = blockIdx.x;
    if (c < AT_NCH) attn_load(c, Kb, Vt, tid, kreg, vreg);
    for (; c < AT_NCH; c += G) {
        asm volatile("s_waitcnt lgkmcnt(0)\n\ts_barrier" ::: "memory");
#pragma unroll
        for (int i = 0; i < 4; ++i) {
            const int p = tid + 512 * i;
            *(LAS u32x4*)(lds + ((p >> 3) * AT_KP + (p & 7) * 8) * 2) = kreg[i];
            *(LAS u32x4*)(lds + AT_VOFF + ((p >> 5) * AT_VP + (p & 31) * 8) * 2) = vreg[i];
        }
        if (c + G < AT_NCH) attn_load(c + G, Kb, Vt, tid, kreg, vreg);
        asm volatile("s_waitcnt lgkmcnt(0)\n\ts_barrier" ::: "memory");
        const int bk = c / (SEQ / 128), qc = c - bk * (SEQ / 128), b = bk >> 2, kvh = bk & 3;
#pragma unroll 1
        for (int it = 0; it < 2; ++it) attn_item(b, kvh * 4 + (wave >> 1), qc, (wave & 1) * 2 + it, Q, lds, sinks, O, lane);
    }
}
__device__ __forceinline__ void final_norm(const bf16_t* __restrict__ XBp, float* __restrict__ out, const float* __restrict__ gfin, int wave, int lane, int G) {
    asm volatile("" : "+v"(lane));
    const int gw = blockIdx.x * NWAVES + wave, NGW = G * NWAVES;
    f32x4 gv[4];
#pragma unroll
    for (int h = 0; h < 2; ++h) { gv[2 * h] = *(const f32x4*)(gfin + 512 * h + 8 * lane); gv[2 * h + 1] = *(const f32x4*)(gfin + 512 * h + 8 * lane + 4); }
    for (int row = gw; row < M; row += 4 * NGW) {
        u32x4 raw[4][2];
#pragma unroll
        for (int q = 0; q < 4; ++q)
#pragma unroll
            for (int h = 0; h < 2; ++h) raw[q][h] = (row + q * NGW < M) ? *(const u32x4*)(XBp + (size_t)(row + q * NGW) * D + 512 * h + 8 * lane) : (u32x4){0u, 0u, 0u, 0u};
#pragma unroll
        for (int q = 0; q < 4; ++q) {
            const int r = row + q * NGW;
            float v[2][8]; float s = 0.f;
#pragma unroll
            for (int h = 0; h < 2; ++h) { pg8::unpack8f(raw[q][h], v[h]);
#pragma unroll
                for (int i = 0; i < 8; ++i) s += v[h][i] * v[h][i]; }
            const float rs = 1.0f / sqrtf(wave_sum(s) * (1.0f / D) + pg8::RMS_EPS_F);
            if (r < M) {
#pragma unroll
                for (int h = 0; h < 2; ++h) {
                    float* o = out + (size_t)r * D + 512 * h + 8 * lane;
                    *(f32x4*)o = (f32x4){v[h][0], v[h][1], v[h][2], v[h][3]} * rs * gv[2 * h];
                    *(f32x4*)(o + 4) = (f32x4){v[h][4], v[h][5], v[h][6], v[h][7]} * rs * gv[2 * h + 1];
                }
            }
        }
    }
}
#define XB_TMO      128
#define XB_XCNT(j)  (256  + 64 * (j))
#define XB_XSUB(j)  (1280 + 64 * (j))
#define XB_XGEN(j)  (2304 + 64 * (j))
#define XB_TOP      3328
#define XB_TOPGEN   3392
#define XCD_BAR_WORDS 3456
#define XB_SPIN_CAP (1u << 18)

__device__ __forceinline__ unsigned xb_ld(unsigned* p)              { return __hip_atomic_load(p, __ATOMIC_RELAXED, __HIP_MEMORY_SCOPE_AGENT); }
__device__ __forceinline__ unsigned xb_add(unsigned* p, unsigned v) { return __hip_atomic_fetch_add(p, v, __ATOMIC_RELAXED, __HIP_MEMORY_SCOPE_AGENT); }
__device__ __forceinline__ unsigned xb_xcc_id() { return (unsigned)__builtin_amdgcn_s_getreg((3 << 11) | 20) & 0xFu; }
#define XB_SPIN(cond, bar) do { unsigned _sp = 0; while (cond) { __builtin_amdgcn_s_sleep(1); \
    if ((++_sp & 255u) == 0u) { if (xb_ld(&(bar)[XB_TMO])) break; if (_sp > XB_SPIN_CAP) { atomicAdd(&(bar)[XB_TMO], 1u); break; } } } } while (0)

struct XcdBarrier {
    unsigned* bar; unsigned x;
    volatile LAS unsigned* st;
};

__device__ __forceinline__ XcdBarrier xcd_barrier_post(unsigned* bar, volatile LAS unsigned* st) {
    XcdBarrier b; b.bar = bar; b.x = xb_xcc_id(); b.st = st;
    if (threadIdx.x == 0) (void)xb_add(&bar[XB_XCNT(b.x)], 1u);
    return b;
}
__device__ __forceinline__ void xcd_barrier_complete(unsigned* bar, unsigned x, unsigned& nloc, unsigned& nx) {
    const unsigned G = gridDim.x * gridDim.y * gridDim.z;
    unsigned sum, cnt, mine, sp = 0u;
    for (;;) {
        sum = 0u; cnt = 0u; mine = 0u;
#pragma unroll
        for (unsigned j = 0; j < 16; ++j) { const unsigned c = xb_ld(&bar[XB_XCNT(j)]); sum += c; cnt += (c > 0u) ? 1u : 0u; mine = (j == x) ? c : mine; }
        if (sum == G) break;
        __builtin_amdgcn_s_sleep(1);
        if ((++sp & 255u) == 0u) { if (xb_ld(&bar[XB_TMO])) break; if (sp > XB_SPIN_CAP) { atomicAdd(&bar[XB_TMO], 1u); break; } }
    }
    nloc = mine > 0u ? mine : 1u; nx = cnt > 0u ? cnt : 1u;
}

__device__ __forceinline__ void xcd_barrier(const XcdBarrier& b) {
    asm volatile("s_waitcnt vmcnt(0)" ::: "memory");
    __syncthreads();
    if (threadIdx.x == 0) {
        unsigned* bar = b.bar;
        __builtin_amdgcn_s_waitcnt(0);
        unsigned nloc = b.st[0], nx = b.st[1];
        if (nloc == 0u) { xcd_barrier_complete(bar, b.x, nloc, nx); b.st[0] = nloc; b.st[1] = nx; }
        const unsigned old = xb_add(&bar[XB_XSUB(b.x)], 1u);
        const unsigned gen = old / nloc;
        if (old + 1u == (gen + 1u) * nloc) {
            __builtin_amdgcn_fence(__ATOMIC_RELEASE, "agent");
            asm volatile("s_waitcnt vmcnt(0)" ::: "memory");
            const unsigned og = xb_add(&bar[XB_TOP], 1u);
            const unsigned tg = og / nx;
            if (og + 1u == (tg + 1u) * nx) xb_add(&bar[XB_TOPGEN], 1u);
            else XB_SPIN(xb_ld(&bar[XB_TOPGEN]) == tg, bar);
            __builtin_amdgcn_fence(__ATOMIC_ACQUIRE, "agent");
            xb_add(&bar[XB_XGEN(b.x)], 1u);
            asm volatile("s_waitcnt vmcnt(0)" ::: "memory");
        } else {
            XB_SPIN(xb_ld(&bar[XB_XGEN(b.x)]) == gen, bar);
            __builtin_amdgcn_fence(__ATOMIC_ACQUIRE, "agent");
            asm volatile("s_waitcnt vmcnt(0)" ::: "memory");
        }
    }
    __syncthreads();
}
#define GSYNC() xcd_barrier(bar)
__global__ void __launch_bounds__(NTHREADS, 2) fwd_megakernel(Params P) {
    extern __shared__ __attribute__((aligned(16))) unsigned char lds_raw[];
    LAS unsigned char* lds = (LAS unsigned char*)lds_raw;
    cg::grid_group grid = cg::this_grid();
    const int tid = threadIdx.x, lane = tid & 63, wave = __builtin_amdgcn_readfirstlane(tid >> 6), G = gridDim.x;
    unsigned char* ws = P.ws;
    bf16_t* XB = (bf16_t*)(ws + WS_XB); pg8::u64_t* SS = (pg8::u64_t*)(ws + WS_SS); const float* CS = (const float*)(ws + WS_CS);
    bf16_t* ACT = (bf16_t*)(ws + WS_BIG);
    bf16_t* Qb = (bf16_t*)(ws + WS_BIG); bf16_t* Kb = (bf16_t*)(ws + WS_BIG + (size_t)M * D * 2); bf16_t* Vt = (bf16_t*)(ws + WS_BIG + (size_t)M * D * 2 + (size_t)M * 256 * 2);
    bf16_t* Ob = (bf16_t*)(ws + WS_BIG + (size_t)M * D * 2 + (size_t)M * 512 * 2);
    bf16_t* Zb = (bf16_t*)(ws + WS_BIG); bf16_t* Bg = (bf16_t*)(ws + WS_BIG + (size_t)M * D * 2);

    unsigned* barw = (unsigned*)(ws + WS_CTL);
    if (blockIdx.x == 0) for (int i = tid; i < XCD_BAR_WORDS; i += NTHREADS) __hip_atomic_store(barw + i, 0u, __ATOMIC_RELAXED, __HIP_MEMORY_SCOPE_AGENT);
    volatile LAS unsigned* bst = (volatile LAS unsigned*)(lds + LDS_BYTES - 64);
    if (tid < 2) bst[tid] = 0u;
    prologue(P, lds, wave, lane, G);
#ifdef PROBE_PRO2
    __syncthreads(); prologue(P, lds, wave, lane, G);
#endif
    __threadfence();
    __syncthreads();
    grid.sync();
    const XcdBarrier bar = xcd_barrier_post(barw, bst);

    for (int st = 0; st < 3 * DEPTH; ++st) {
        const int l = st / 3, sub = st - 3 * l, j = l >> 1;
        const bool is_ffn = sub != 1, is_conv = (l & 1) == 0;
#ifdef PROBE_G1X2
        for (int rep = 0; rep < 2; ++rep) {
#endif
#ifndef NO_G1
        if (is_ffn) {
            const int which = sub == 2;
            pg8::Gemm g{XB, (const bf16_t*)(ws + WS_WFFIN + (size_t)(l * 2 + which) * SZ_WFFIN), M, NFFIN, D};
            pg8::StaticOrder S; S.init(M, NFFIN, G, (int)blockIdx.x);
            pg8::EpiSwiGLU E{ACT, SS, FF, {(LAS float*)(lds + pg8::STAGE_BYTES + 4096 + wave * 512), -1}};
            pg8::gemm_phase<pg8::EpiSwiGLU, pg8::StaticOrder, true, true>(lds, g, S, E);
        }
#endif
#ifndef NO_G2
        if (!is_ffn && is_conv) {
            pg8::Gemm g{XB, (const bf16_t*)(ws + WS_WCIN + (size_t)j * SZ_WCIN), M, NCIN, D};
            pg8::StaticOrder S; S.init(M, NCIN, G, (int)blockIdx.x);
            pg8::EpiConvIn E{Zb, Bg, SS, {(LAS float*)(lds + pg8::STAGE_BYTES + 4096 + wave * 512), -1}};
            pg8::gemm_phase<pg8::EpiConvIn, pg8::StaticOrder, true, true>(lds, g, S, E);
        }
#endif
#ifndef NO_G3
        if (!is_ffn && !is_conv) {
            const bf16_t* Wq = (const bf16_t*)(ws + WS_WQKV + (size_t)j * SZ_WQKV);
            pg8::Gemm g{XB, Wq, M, NQKV, D, Wq + (size_t)1280 * D, XB};
            pg8::QkvOrder S; S.init(M, G, (int)blockIdx.x);
            pg8::EpiQKV E{Qb, Kb, Vt, SS, CS, SEQ, {(LAS float*)(lds + pg8::STAGE_BYTES + 4096 + wave * 512), -1}};
            pg8::gemm_phase<pg8::EpiQKV, pg8::QkvOrder, true, true>(lds, g, S, E);
        }
#endif
        GSYNC();
#ifdef PROBE_G1X2
        }
#endif
        if (!is_ffn) {
#ifndef NO_CONV
            if (is_conv) conv_phase(Zb, Bg, P.conv_kernel + (size_t)j * 3 * D, tid, G);
#endif
#ifndef NO_ATTN
            if (!is_conv) attn_phase(Qb, Kb, Vt, P.attn_sinks + j * 16, Ob, lds, tid, wave, lane, G);
#ifdef PROBE_ATT2
            if (!is_conv) attn_phase(Qb, Kb, Vt, P.attn_sinks + j * 16, Ob, lds, tid, wave, lane, G);
#endif
#endif
            GSYNC();
        }
#ifndef NO_G4
        {
            const bf16_t* A; const bf16_t* Bt; int K; float scale;
            if (is_ffn) { A = ACT; Bt = (const bf16_t*)(ws + WS_WFFOUT + (size_t)(l * 2 + (sub == 2)) * SZ_WFFOUT); K = FF; scale = 0.5f; }
            else if (is_conv) { A = Bg; Bt = (const bf16_t*)(ws + WS_WCOUT + (size_t)j * SZ_WSQ); K = D; scale = 1.0f; }
            else { A = Ob; Bt = (const bf16_t*)(ws + WS_WO + (size_t)j * SZ_WSQ); K = D; scale = 1.0f; }
            pg8::Gemm g{A, Bt, M, D, K};
            pg8::StaticOrder S; S.init(M, D, G, (int)blockIdx.x);
            pg8::EpiResid E{XB, SS, scale};
            pg8::gemm_phase<pg8::EpiResid, pg8::StaticOrder, true, true>(lds, g, S, E);
        }
#endif
        GSYNC();
    }
    final_norm(XB, P.out, P.ln_final, wave, lane, G);
}

extern "C" void kernel_launch(void* const* d_in, const int* in_sizes, int n_in, void* d_out, int out_size, void* d_ws, size_t ws_size, hipStream_t stream) {
    static int grid = 0;
    if (grid == 0) {
        if (n_in != 16 || in_sizes[0] != M * D || out_size != M * D || ws_size < WS_END) { fprintf(stderr, "kernel_launch: unexpected shapes (n_in %d, in0 %d, out %d, ws %zu, need %zu)\n", n_in, n_in > 0 ? in_sizes[0] : -1, out_size, ws_size, (size_t)WS_END); grid = -1; return; }
        int dev = 0, cus = 0, per_cu = 0;
        (void)hipGetDevice(&dev);
        (void)hipDeviceGetAttribute(&cus, hipDeviceAttributeMultiprocessorCount, dev);
        if (hipFuncSetAttribute((const void*)fwd_megakernel, hipFuncAttributeMaxDynamicSharedMemorySize, LDS_BYTES) != hipSuccess) { fprintf(stderr, "kernel_launch: hipFuncSetAttribute failed\n"); grid = -1; return; }
        if (hipOccupancyMaxActiveBlocksPerMultiprocessor(&per_cu, (const void*)fwd_megakernel, NTHREADS, LDS_BYTES) != hipSuccess || per_cu < 1) { fprintf(stderr, "kernel_launch: occupancy query says %d\n", per_cu); per_cu = 1; }
        (void)hipGetLastError();
        grid = cus * per_cu;
    }
    if (grid < 0) return;
    Params p{};
    p.x = (const float*)d_in[0]; p.pos = (const int*)d_in[1]; p.ln_ff1 = (const float*)d_in[2]; p.w_ff1_in = (const float*)d_in[3]; p.w_ff1_out = (const float*)d_in[4];
    p.ln_mix = (const float*)d_in[5]; p.ln_ff2 = (const float*)d_in[6]; p.w_ff2_in = (const float*)d_in[7]; p.w_ff2_out = (const float*)d_in[8];
    p.conv_w_in = (const float*)d_in[9]; p.conv_kernel = (const float*)d_in[10]; p.conv_w_out = (const float*)d_in[11];
    p.attn_w_qkv = (const float*)d_in[12]; p.attn_sinks = (const float*)d_in[13]; p.attn_w_o = (const float*)d_in[14]; p.ln_final = (const float*)d_in[15];
    p.out = (float*)d_out; p.ws = (unsigned char*)d_ws;
    void* args[] = {&p};
    hipError_t e = hipLaunchCooperativeKernel((const void*)fwd_megakernel, dim3(grid), dim3(NTHREADS), args, LDS_BYTES, stream);
    if (e != hipSuccess) fprintf(stderr, "cooperative launch failed: %s (grid %d)\n", hipGetErrorString(e), grid);
}
```

```cpp
#include <hip/hip_runtime.h>
#include <hip/hip_cooperative_groups.h>
#include <cstdio>
#include <cstdint>
#include <cmath>
namespace cg = cooperative_groups;
namespace pg8 {
#define PG8_LAS __attribute__((address_space(3)))
typedef unsigned short bf16_t;
typedef short bf16x8 __attribute__((ext_vector_type(8)));
typedef float f32x4 __attribute__((ext_vector_type(4)));
typedef unsigned u32x4 __attribute__((ext_vector_type(4)));
constexpr int BM = 256, BK = 64, HALF = 128, HTB = HALF * BK * 2  , STAGE_BYTES = 8 * HTB, NXCD = 8, WGM = 8;

__host__ __device__ __forceinline__ int lds_byte(int r, int c) { const int st = (r >> 4) * 2 + (c >> 5), rr = r & 15, cc = c & 31, ob = rr * 64 + cc * 2; return st * 1024 + (ob ^ (((ob >> 9) & 1) << 5)); }
__host__ __device__ __forceinline__ void stage_rc(int b, int& R, int& C) { const int st = b / 1024, sb = b % 1024, swz = sb ^ (((sb >> 9) & 1) << 5); R = (st >> 1) * 16 + swz / 64; C = (st & 1) * 32 + (swz % 64) / 2; }
__host__ __device__ __forceinline__ int perm32(int rho) { const int n = rho >> 4, i = rho & 15; return 8 * (i >> 2) + 4 * n + (i & 3); }

struct Unit { int pm, pn, sw; };
struct Gemm { const bf16_t* A; const bf16_t* Bt; int M, N, K; const bf16_t* A2; const bf16_t* Bt2; };

struct StaticOrder {
    int nM, nN, nwg, G, c;
    __host__ __device__ void init(int M, int N, int G_, int c_) { nM = M / BM; nN = N / BM; nwg = nM * nN; G = G_; c = c_; }
    __host__ __device__ bool next(int i, Unit& u) const {
        const long L = (long)i * G + c; if (L >= nwg) return false;
        int wgid = (int)L; { const int q = nwg / NXCD, r = nwg % NXCD, xcd = wgid % NXCD, off = wgid / NXCD; wgid = (xcd < r ? xcd * (q + 1) : r * (q + 1) + (xcd - r) * q) + off; }
        const int nig = WGM * nN, gid = wgid / nig, fm = gid * WGM, gsz = (nM - fm) < WGM ? (nM - fm) : WGM;
        u.pm = fm + ((wgid % nig) % gsz); u.pn = (wgid % nig) / gsz; u.sw = 0; return true;
    }
    __device__ __forceinline__ void a_ready(const Unit&) const {}
    __device__ __forceinline__ void done(const Unit&) const {}
};
typedef float f32x2 __attribute__((ext_vector_type(2)));
typedef __bf16 bf16x2_t __attribute__((ext_vector_type(2)));
__device__ __forceinline__ unsigned cvt_pk_bf16(float lo, float hi) { const f32x2 v = {lo, hi}; const bf16x2_t b = __builtin_convertvector(v, bf16x2_t); return __builtin_bit_cast(unsigned, b); }
template <class Epi, class Sched, bool ALIGN_EPI = false, bool SP2 = false>
__device__ __forceinline__ void gemm_phase(PG8_LAS unsigned char* lds, const Gemm g, const Sched& S, const Epi& E) {
    int tid_ = threadIdx.x; asm volatile("" : "+v"(tid_));
    const int tid = tid_, wid = __builtin_amdgcn_readfirstlane(tid >> 6), lane = tid & 63, wr = wid >> 2, wc = wid & 3, fr = lane & 15, fq = lane >> 4;
    const int K = g.K, nt = K / BK;
    unsigned voffA[2], voffB[2];
#pragma unroll
    for (int i = 0; i < 2; ++i) { int R, C; stage_rc(tid * 16 + i * 8192, R, C); const int Rb = Epi::PERM ? ((R & ~31) + perm32(R & 31)) : R;
        voffA[i] = (unsigned)(R * K + C) * 2u; voffB[i] = (unsigned)(Rb * K + C) * 2u; }
    const size_t kstep = (size_t)(BK * 2);
    const size_t hstep = (size_t)HALF * K * 2;
    const size_t tstep = 2 * hstep;
    const unsigned ldsw = (unsigned)wid * 1024u;
    const int aoff = lds_byte(wr * 64 + fr, fq * 8), boff = lds_byte(wc * 32 + fr, fq * 8);
#define PG8_SA(b, h) (((b) * 2 + (h)) * HTB)
#define PG8_SB(b, h) ((4 + (b) * 2 + (h)) * HTB)
#define PG8_STAGE(bufoff, gbase, voff) do { _Pragma("unroll") for (int _i = 0; _i < 2; ++_i) \
        __builtin_amdgcn_global_load_lds((const unsigned*)((const char*)(gbase) + (voff)[_i]), (PG8_LAS unsigned*)(lds + (bufoff) + ldsw + _i * 8192), 16, 0, 0); } while (0)
#define PG8_LDA(dst, b, h) do { _Pragma("unroll") for (int m = 0; m < 4; ++m) _Pragma("unroll") for (int k = 0; k < 2; ++k) dst[m][k] = *(const PG8_LAS bf16x8*)(lds + PG8_SA(b, h) + aoff + m * 2048 + k * 1024); } while (0)
#define PG8_LDB(dst, b, h) do { _Pragma("unroll") for (int n = 0; n < 2; ++n) _Pragma("unroll") for (int k = 0; k < 2; ++k) dst[n][k] = *(const PG8_LAS bf16x8*)(lds + PG8_SB(b, h) + boff + n * 2048 + k * 1024); } while (0)
#define PG8_MMA(ai, bj, At, Bt) do { __builtin_amdgcn_s_setprio(1); _Pragma("unroll") for (int m = 0; m < 4; ++m) _Pragma("unroll") for (int n = 0; n < 2; ++n) _Pragma("unroll") for (int k = 0; k < 2; ++k) \
        acc[ai][bj][m][n] = __builtin_amdgcn_mfma_f32_16x16x32_bf16(Bt[n][k], At[m][k], acc[ai][bj][m][n], 0, 0, 0); __builtin_amdgcn_s_setprio(0); } while (0)
#define PG8_WAIT_V(n) asm volatile("s_waitcnt vmcnt(" #n ")" ::: "memory")
#define PG8_WAIT_L(n) asm volatile("s_waitcnt lgkmcnt(" #n ")" ::: "memory")
#define PG8_BAR __builtin_amdgcn_s_barrier()
#define PG8_SCHED __builtin_amdgcn_sched_barrier(0)
    Unit cur, nxt; int ui = 0;
    if (!S.next(0, cur)) return;
    f32x4 acc[2][2][4][2];
#pragma unroll
    for (int a = 0; a < 2; ++a)
#pragma unroll
        for (int b = 0; b < 2; ++b)
#pragma unroll
            for (int m = 0; m < 4; ++m)
#pragma unroll
                for (int n = 0; n < 2; ++n) acc[a][b][m][n] = (f32x4){0.f, 0.f, 0.f, 0.f};
    bf16x8 At[4][2], B0[2][2], B1[2][2];
    const char* cA = (const char*)(cur.sw ? g.A2 : g.A) + (size_t)cur.pm * tstep; const char* cB = (const char*)(cur.sw ? g.Bt2 : g.Bt) + (size_t)cur.pn * tstep;
    S.a_ready(cur);
    if constexpr (SP2) {
        PG8_STAGE(PG8_SB(0, 0), cB, voffB); PG8_STAGE(PG8_SB(0, 1), cB + hstep, voffB); PG8_STAGE(PG8_SA(0, 0), cA, voffA); PG8_STAGE(PG8_SA(0, 1), cA + hstep, voffA);
        if (wr == 1) PG8_BAR;
        PG8_WAIT_V(2); PG8_BAR;
        PG8_STAGE(PG8_SB(1, 0), cB + kstep, voffB); PG8_STAGE(PG8_SA(1, 0), cA + kstep, voffA); PG8_STAGE(PG8_SB(1, 1), cB + hstep + kstep, voffB);
        PG8_WAIT_V(6); PG8_BAR;
    } else {
        PG8_STAGE(PG8_SB(0, 0), cB, voffB); PG8_STAGE(PG8_SA(0, 0), cA, voffA); PG8_STAGE(PG8_SB(0, 1), cB + hstep, voffB); PG8_STAGE(PG8_SA(0, 1), cA + hstep, voffA);
        if (wr == 1) PG8_BAR;
        PG8_WAIT_V(4); PG8_BAR;
        PG8_STAGE(PG8_SB(1, 0), cB + kstep, voffB); PG8_STAGE(PG8_SA(1, 0), cA + kstep, voffA); PG8_STAGE(PG8_SB(1, 1), cB + hstep + kstep, voffB);
        PG8_WAIT_V(6); PG8_BAR;
    }
    for (;;) {
        const bool has_next = S.next(ui + 1, nxt);
        const char* nA = has_next ? (const char*)(nxt.sw ? g.A2 : g.A) + (size_t)nxt.pm * tstep : cA; const char* nB = has_next ? (const char*)(nxt.sw ? g.Bt2 : g.Bt) + (size_t)nxt.pn * tstep : cB;
        for (int t = 0; t < nt; t += 2) {
            if constexpr (Epi::PF_TRIPS > 0) { if (t == nt - 2 * Epi::PF_TRIPS) E.prefetch(cur, tid, lds + STAGE_BYTES + wid * 512); }
            const bool last = (t == nt - 2);
            const char* a1 = cA + (size_t)(t + 1) * kstep;
            const char* a2 = last ? nA : cA + (size_t)(t + 2) * kstep; const char* b2 = last ? nB : cB + (size_t)(t + 2) * kstep;
            const char* a3 = a2 + kstep; const char* b3 = b2 + kstep;
            if (last && has_next) S.a_ready(nxt);
            if constexpr (SP2) {
            PG8_LDB(B0, 0, 0); PG8_LDB(B1, 0, 1); PG8_SCHED; PG8_LDA(At, 0, 0); PG8_STAGE(PG8_SA(1, 1), a1 + hstep, voffA);
            PG8_WAIT_V(8); PG8_WAIT_L(0); PG8_BAR; PG8_MMA(0, 0, At, B0); PG8_MMA(0, 1, At, B1); PG8_BAR; PG8_SCHED;
            PG8_LDA(At, 0, 1); PG8_STAGE(PG8_SB(0, 0), b2, voffB); PG8_STAGE(PG8_SB(0, 1), b2 + hstep, voffB); PG8_STAGE(PG8_SA(0, 0), a2, voffA);
            PG8_WAIT_V(8); PG8_WAIT_L(0); PG8_BAR; PG8_MMA(1, 0, At, B0); PG8_MMA(1, 1, At, B1); PG8_BAR; PG8_SCHED;
            PG8_LDB(B0, 1, 0); PG8_LDB(B1, 1, 1); PG8_SCHED; PG8_LDA(At, 1, 0); PG8_STAGE(PG8_SA(0, 1), a2 + hstep, voffA);
            PG8_WAIT_V(8); PG8_WAIT_L(0); PG8_BAR; PG8_MMA(0, 0, At, B0); PG8_MMA(0, 1, At, B1); PG8_BAR; PG8_SCHED;
            PG8_LDA(At, 1, 1); PG8_STAGE(PG8_SB(1, 0), b3, voffB); PG8_STAGE(PG8_SB(1, 1), b3 + hstep, voffB); PG8_STAGE(PG8_SA(1, 0), a3, voffA);
            PG8_WAIT_V(8); PG8_WAIT_L(0); PG8_BAR; PG8_MMA(1, 0, At, B0); PG8_MMA(1, 1, At, B1); PG8_BAR; PG8_SCHED;
            } else {
            PG8_LDB(B0, 0, 0); PG8_SCHED; PG8_LDA(At, 0, 0); PG8_STAGE(PG8_SA(1, 1), a1 + hstep, voffA);
            PG8_WAIT_L(8); PG8_BAR; PG8_WAIT_L(0); PG8_MMA(0, 0, At, B0); PG8_BAR; PG8_SCHED;
            PG8_LDB(B1, 0, 1); PG8_STAGE(PG8_SB(0, 0), b2, voffB);
            PG8_BAR; PG8_WAIT_L(0); PG8_MMA(0, 1, At, B1); PG8_BAR;
            PG8_LDA(At, 0, 1); PG8_STAGE(PG8_SA(0, 0), a2, voffA);
            PG8_BAR; PG8_WAIT_L(0); PG8_MMA(1, 0, At, B0); PG8_BAR; PG8_SCHED;
            PG8_STAGE(PG8_SB(0, 1), b2 + hstep, voffB);
            PG8_WAIT_V(6); PG8_BAR; PG8_MMA(1, 1, At, B1); PG8_BAR;
            PG8_LDB(B0, 1, 0); PG8_SCHED; PG8_LDA(At, 1, 0); PG8_STAGE(PG8_SA(0, 1), a2 + hstep, voffA);
            PG8_WAIT_L(8); PG8_BAR; PG8_WAIT_L(0); PG8_MMA(0, 0, At, B0); PG8_BAR; PG8_SCHED;
            PG8_LDB(B1, 1, 1); PG8_STAGE(PG8_SB(1, 0), b3, voffB);
            PG8_BAR; PG8_WAIT_L(0); PG8_MMA(0, 1, At, B1); PG8_BAR;
            PG8_LDA(At, 1, 1); PG8_STAGE(PG8_SA(1, 0), a3, voffA);
            PG8_BAR; PG8_WAIT_L(0); PG8_MMA(1, 0, At, B0); PG8_BAR; PG8_SCHED;
            PG8_STAGE(PG8_SB(1, 1), b3 + hstep, voffB);
            PG8_WAIT_V(6); PG8_BAR; PG8_MMA(1, 1, At, B1); PG8_BAR;
            }
        }
        if constexpr (ALIGN_EPI) { if (wr == 0) PG8_BAR; }
        if constexpr (!Epi::AFTER_DRAIN) { E(acc, cur, wr, wc, fr, fq); S.done(cur); }
        if (!has_next) break;
#pragma unroll
        for (int a = 0; a < 2; ++a)
#pragma unroll
            for (int b = 0; b < 2; ++b)
#pragma unroll
                for (int m = 0; m < 4; ++m)
#pragma unroll
                    for (int n = 0; n < 2; ++n) acc[a][b][m][n] = (f32x4){0.f, 0.f, 0.f, 0.f};
        cur = nxt; cA = nA; cB = nB; ++ui;
        if constexpr (ALIGN_EPI) { if (wr == 1) PG8_BAR; }
    }
    PG8_WAIT_V(0);
    if constexpr (!ALIGN_EPI) { if (wr == 0) PG8_BAR; }
    PG8_BAR;
    if constexpr (Epi::AFTER_DRAIN) { E.fused(acc, cur, wr, wc, fr, fq, lds, wid, lane); S.done(cur); }
#undef PG8_SA
#undef PG8_SB
#undef PG8_STAGE
#undef PG8_LDA
#undef PG8_LDB
#undef PG8_MMA
#undef PG8_WAIT_V
#undef PG8_WAIT_L
#undef PG8_BAR
#undef PG8_SCHED
}
}
namespace pg8 {
constexpr float RMS_EPS_F = 1e-6f;
constexpr float LOG2E_F = 1.4426950408889634f;
constexpr float QSCALE_F = 0.125f * 1.4426950408889634f;
typedef float u64_t;
__device__ __forceinline__ float rstd_row(const u64_t* ssp, int row) {
    const f32x4* p = (const f32x4*)(ssp + (size_t)row * 16);
    const f32x4 a = p[0], b = p[1], c = p[2], d = p[3];
    const f32x4 s = (a + b) + (c + d);
    const float t = (s[0] + s[1]) + (s[2] + s[3]);
    return __builtin_amdgcn_rsqf(t * (1.0f / 1024.0f) + RMS_EPS_F);
}
struct RstdTab {
    PG8_LAS float* tab; mutable int cpm;
    __device__ __forceinline__ void refresh(const u64_t* ssq, int pm, int wr, int fr, int fq) const {
        if (pm != cpm) {
            cpm = pm;
            const int lane = fr + 16 * fq;
#pragma unroll
            for (int h = 0; h < 2; ++h) { const int idx = lane + 64 * h, am = idx >> 4, f = idx & 15;
                tab[idx] = rstd_row(ssq, pm * BM + (am >> 2) * HALF + wr * 64 + (am & 3) * 16 + f); }
        }
    }
    __device__ __forceinline__ float get(int ai, int m, int fr) const { return tab[(ai * 4 + m) * 16 + fr]; }
};
__device__ __forceinline__ u32x4 pack8(const float (&o)[8]) {
    u32x4 w; w.x = cvt_pk_bf16(o[0], o[1]); w.y = cvt_pk_bf16(o[2], o[3]); w.z = cvt_pk_bf16(o[4], o[5]); w.w = cvt_pk_bf16(o[6], o[7]); return w;
}
struct EpiSwiGLU {
    static constexpr bool PERM = true, AFTER_DRAIN = false; static constexpr int PF_TRIPS = 0;
    bf16_t* O; const u64_t* ssp; int ldo; RstdTab rt;
    __device__ __forceinline__ void operator()(const f32x4 (&acc)[2][2][4][2], const Unit& u, int wr, int wc, int fr, int fq) const {
        asm volatile("" : "+v"(fr), "+v"(fq));
        const int row0 = u.pm * BM + wr * 64 + fr, col0 = u.pn * 128 + wc * 32 + 8 * fq;
        rt.refresh(ssp, u.pm, wr, fr, fq);
#pragma unroll
        for (int ai = 0; ai < 2; ++ai)
#pragma unroll
            for (int m = 0; m < 4; ++m) {
                const int row = row0 + ai * HALF + m * 16;
                const float rs = rt.get(ai, m, fr), rsl = rs * -LOG2E_F, irs2 = __builtin_amdgcn_rcpf(rs * rs);
                float o[8];
#pragma unroll
                for (int n = 0; n < 2; ++n) {
                    const f32x4 a = acc[ai][0][m][n], b = acc[ai][1][m][n];
                    const f32x4 t = a * rsl, ab = a * b;
                    f32x4 e; e[0] = __builtin_amdgcn_exp2f(t[0]); e[1] = __builtin_amdgcn_exp2f(t[1]); e[2] = __builtin_amdgcn_exp2f(t[2]); e[3] = __builtin_amdgcn_exp2f(t[3]);
                    const f32x4 d = e * irs2 + irs2;
                    f32x4 r; r[0] = __builtin_amdgcn_rcpf(d[0]); r[1] = __builtin_amdgcn_rcpf(d[1]); r[2] = __builtin_amdgcn_rcpf(d[2]); r[3] = __builtin_amdgcn_rcpf(d[3]);
                    const f32x4 q = ab * r;
                    o[n * 4 + 0] = q[0]; o[n * 4 + 1] = q[1]; o[n * 4 + 2] = q[2]; o[n * 4 + 3] = q[3];
                }
                { const u32x4 pk_ = pack8(o); *(u32x4*)(O + (size_t)row * ldo + col0) = pk_;
#ifdef PROBE_ST2
                  *(volatile u32x4*)(O + (size_t)row * ldo + col0) = pk_;
#endif
                }
            }
    }
};
__device__ __forceinline__ void unpack8f(const u32x4 w, float (&f)[8]) {
    f[0] = __uint_as_float(w.x << 16); f[1] = __uint_as_float(w.x & 0xffff0000u); f[2] = __uint_as_float(w.y << 16); f[3] = __uint_as_float(w.y & 0xffff0000u);
    f[4] = __uint_as_float(w.z << 16); f[5] = __uint_as_float(w.z & 0xffff0000u); f[6] = __uint_as_float(w.w << 16); f[7] = __uint_as_float(w.w & 0xffff0000u);
}
struct EpiResid {
    static constexpr bool PERM = true, AFTER_DRAIN = false; static constexpr int PF_TRIPS = 4;
    bf16_t* xb; u64_t* ssq; float scale;
    __device__ __forceinline__ void prefetch(const Unit& u, int tid, PG8_LAS unsigned char* scratch) const {
        const bf16_t* sb = xb + ((size_t)(u.pm * BM) * 1024 + u.pn * BM);
        const unsigned voff = (unsigned)(((tid >> 2) * 1024 + (tid & 3) * 64) * 2);
        const unsigned l0 = (unsigned)__builtin_amdgcn_readfirstlane((int)(unsigned)(uintptr_t)scratch);
        const bf16_t* sb2 = sb + (size_t)128 * 1024;
        unsigned keep;
        asm volatile("s_mov_b32 %0, m0\n\ts_mov_b32 m0, %3\n\ts_nop 0\n\tglobal_load_lds_dword %1, %2\n\ts_mov_b32 m0, %5\n\ts_nop 0\n\tglobal_load_lds_dword %1, %4\n\ts_mov_b32 m0, %0"
                     : "=&s"(keep) : "v"(voff), "s"(sb), "s"(l0), "s"(sb2), "s"(l0 + 256u) : "memory");
    }
    __device__ __forceinline__ void operator()(const f32x4 (&acc)[2][2][4][2], const Unit& u, int wr, int wc, int fr, int fq) const {
        asm volatile("" : "+v"(fr), "+v"(fq));
        const int row0 = u.pm * BM + wr * 64 + fr, col0 = u.pn * BM + wc * 32 + 8 * fq;
#pragma unroll
        for (int ai = 0; ai < 2; ++ai) {
            u32x4 bx[4][2];
#pragma unroll
            for (int m = 0; m < 4; ++m)
#pragma unroll
                for (int bj = 0; bj < 2; ++bj) bx[m][bj] = *(const u32x4*)(xb + (size_t)(row0 + ai * HALF + m * 16) * 1024 + col0 + bj * HALF);
#pragma unroll
            for (int m = 0; m < 4; ++m) {
                const int row = row0 + ai * HALF + m * 16;
                float ss = 0.f;
#pragma unroll
                for (int bj = 0; bj < 2; ++bj) {
                    const size_t off = (size_t)row * 1024 + col0 + bj * HALF;
                    float b[8], v[8]; unpack8f(bx[m][bj], b);
#pragma unroll
                    for (int n = 0; n < 2; ++n)
#pragma unroll
                        for (int j = 0; j < 4; ++j) { const float t = b[n * 4 + j] + acc[ai][bj][m][n][j] * scale; v[n * 4 + j] = t; ss += t * t; }
                    *(u32x4*)(xb + off) = pack8(v);
                }
                ss += __shfl_xor(ss, 16); ss += __shfl_xor(ss, 32);
                if (fq == 0) ssq[(size_t)row * 16 + u.pn * 4 + wc] = ss;
            }
            asm volatile("" ::: "memory");
        }
    }
};
struct EpiConvIn {
    static constexpr bool PERM = true, AFTER_DRAIN = false; static constexpr int PF_TRIPS = 0;
    bf16_t* Z; bf16_t* Bg; const u64_t* ssp; RstdTab rt;
    __device__ __forceinline__ void operator()(const f32x4 (&acc)[2][2][4][2], const Unit& u, int wr, int wc, int fr, int fq) const {
        asm volatile("" : "+v"(fr), "+v"(fq));
        const int row0 = u.pm * BM + wr * 64 + fr;
        rt.refresh(ssp, u.pm, wr, fr, fq);
        if (u.pn < 8) {
            const int col0 = u.pn * 128 + wc * 32 + 8 * fq;
#pragma unroll
            for (int ai = 0; ai < 2; ++ai)
#pragma unroll
                for (int m = 0; m < 4; ++m) {
                    const int row = row0 + ai * HALF + m * 16;
                    const float rs = rt.get(ai, m, fr), rs2 = rs * rs;
                    float o[8];
#pragma unroll
                    for (int n = 0; n < 2; ++n)
#pragma unroll
                        for (int j = 0; j < 4; ++j) o[n * 4 + j] = acc[ai][0][m][n][j] * acc[ai][1][m][n][j] * rs2;
                    *(u32x4*)(Z + (size_t)row * 1024 + col0) = pack8(o);
                }
        } else {
            const int col0 = (u.pn - 8) * BM + wc * 32 + 8 * fq;
#pragma unroll
            for (int ai = 0; ai < 2; ++ai)
#pragma unroll
                for (int m = 0; m < 4; ++m) {
                    const int row = row0 + ai * HALF + m * 16;
                    const float rs = rt.get(ai, m, fr);
#pragma unroll
                    for (int bj = 0; bj < 2; ++bj) {
                        float o[8];
#pragma unroll
                        for (int n = 0; n < 2; ++n)
#pragma unroll
                            for (int j = 0; j < 4; ++j) o[n * 4 + j] = acc[ai][bj][m][n][j] * rs;
                        *(u32x4*)(Bg + (size_t)row * 1024 + col0 + bj * HALF) = pack8(o);
                    }
                }
        }
    }
};
struct EpiQKV {
    static constexpr bool PERM = true, AFTER_DRAIN = false; static constexpr int PF_TRIPS = 0;
    bf16_t* Q; bf16_t* Kb; bf16_t* Vt; const u64_t* ssp; const float* cs; int seq; RstdTab rt;
    __device__ __forceinline__ void operator()(const f32x4 (&acc)[2][2][4][2], const Unit& u, int wr, int wc, int fr, int fq) const {
        asm volatile("" : "+v"(fr), "+v"(fq));
        const int row0 = u.pm * BM + wr * 64 + fr;
        if (!u.sw) {
            const bool isq = u.pn < 4;
            rt.refresh(ssp, u.pm, wr, fr, fq);
            f32x4 tn[4];
            { const f32x4* cp = (const f32x4*)(cs + (size_t)row0 * 64 + 16 * fq); tn[0] = cp[0]; tn[1] = cp[1]; tn[2] = cp[2]; tn[3] = cp[3]; }
#pragma unroll
            for (int it = 0; it < 8; ++it) {
                const int ai = it >> 2, m = it & 3;
                const int row = row0 + ai * HALF + m * 16;
                float rs = rt.get(ai, m, fr); if (isq) rs *= QSCALE_F;
                const f32x4 t0 = tn[0], t1 = tn[1], t2 = tn[2], t3 = tn[3];
                if (it < 7) { const int nrow = row0 + ((it + 1) >> 2) * HALF + ((it + 1) & 3) * 16; const f32x4* cp = (const f32x4*)(cs + (size_t)nrow * 64 + 16 * fq); tn[0] = cp[0]; tn[1] = cp[1]; tn[2] = cp[2]; tn[3] = cp[3]; }
                const float cc[8] = {t0[0], t0[2], t1[0], t1[2], t2[0], t2[2], t3[0], t3[2]};
                const float sn[8] = {t0[1], t0[3], t1[1], t1[3], t2[1], t2[3], t3[1], t3[3]};
                float o1[8], o2[8];
#pragma unroll
                for (int n = 0; n < 2; ++n)
#pragma unroll
                    for (int j = 0; j < 4; ++j) {
                        const int k = n * 4 + j;
                        const float x1 = acc[ai][0][m][n][j] * rs, x2 = acc[ai][1][m][n][j] * rs;
                        o1[k] = x1 * cc[k] - x2 * sn[k]; o2[k] = x2 * cc[k] + x1 * sn[k];
                    }
                bf16_t* dst;
                if (isq) dst = Q + (size_t)row * 1024 + u.pn * 256 + wc * 64 + 8 * fq;
                else { const int b = row / seq, t = row - b * seq; dst = Kb + ((size_t)(b * 4 + wc) * seq + t) * 64 + 8 * fq; }
                *(u32x4*)dst = pack8(o1); *(u32x4*)(dst + 32) = pack8(o2);
            }
        } else {
            { const int tl = fr + 16 * fq; rt.tab[tl] = rstd_row(ssp, u.pn * BM + (tl >> 5) * HALF + wc * 32 + (tl & 31)); rt.cpm = -1; }
#pragma unroll
            for (int bj = 0; bj < 2; ++bj) {
                const int tok0 = u.pn * BM + bj * HALF + wc * 32 + 8 * fq, b = tok0 / seq, t = tok0 - b * seq;
                float rs[8];
#pragma unroll
                for (int k = 0; k < 8; ++k) rs[k] = rt.tab[bj * 32 + 8 * fq + k];
#pragma unroll
                for (int ai = 0; ai < 2; ++ai)
#pragma unroll
                    for (int m = 0; m < 4; ++m) {
                        const int vc = ai * HALF + wr * 64 + m * 16 + fr;
                        float o[8];
#pragma unroll
                        for (int n = 0; n < 2; ++n)
#pragma unroll
                            for (int j = 0; j < 4; ++j) o[n * 4 + j] = acc[ai][bj][m][n][j] * rs[n * 4 + j];
                        *(u32x4*)(Vt + ((size_t)(b * 256 + vc)) * seq + t) = pack8(o);
                    }
                asm volatile("" ::: "memory");
            }
        }
    }
};
struct QkvOrder {
    StaticOrder so; int G, c;
    __host__ __device__ void init(int M, int G_, int c_) { so.init(M, 1280, G_, c_); G = G_; c = c_; }
    __host__ __device__ bool next(int i, Unit& u) const {
        const long L = (long)i * G + c; if (L < so.nwg) return so.next(i, u);
        const int r = (int)(L - so.nwg); if (r >= so.nM) return false;
        u.pm = 0; u.pn = r; u.sw = 1; return true;
    }
    __device__ __forceinline__ void a_ready(const Unit&) const {}
    __device__ __forceinline__ void done(const Unit&) const {}
};
}
constexpr int BATCH = 2, SEQ = 16384, D = 1024, FF = 2816, DEPTH = 4, M = BATCH * SEQ;
constexpr int NQKV = 1536, NCIN = 3072, NFFIN = 2 * FF;
constexpr int NWAVES = 8, NTHREADS = NWAVES * 64;
constexpr int LDS_BYTES = 147456;
constexpr size_t MiB = 1u << 20;
constexpr size_t SZ_WFFIN = (size_t)NFFIN * D * 2, SZ_WFFOUT = (size_t)D * FF * 2, SZ_WCIN = (size_t)NCIN * D * 2, SZ_WSQ = (size_t)D * D * 2, SZ_WQKV = (size_t)NQKV * D * 2;
constexpr size_t WS_WFFIN = 0;
constexpr size_t WS_WFFOUT = WS_WFFIN + 8 * SZ_WFFIN;
constexpr size_t WS_WCIN = WS_WFFOUT + 8 * SZ_WFFOUT;
constexpr size_t WS_WCOUT = WS_WCIN + 2 * SZ_WCIN;
constexpr size_t WS_WQKV = WS_WCOUT + 2 * SZ_WSQ;
constexpr size_t WS_WO = WS_WQKV + 2 * SZ_WQKV;
constexpr size_t WS_XB = WS_WO + 2 * SZ_WSQ;
constexpr int NSSQ = 3 * DEPTH + 1;
constexpr size_t WS_SS = WS_XB + (size_t)M * D * 2;
constexpr size_t WS_CS = WS_SS + (size_t)NSSQ * M * 8;
constexpr size_t WS_BIG = WS_CS + (size_t)M * 64 * 4;
constexpr size_t WS_CTL = WS_BIG + (size_t)M * FF * 2;
constexpr size_t WS_END = WS_CTL + 16384;
static_assert(WS_END <= 440 * MiB, "workspace map");

typedef pg8::bf16_t bf16_t;
typedef pg8::f32x4 f32x4;
typedef pg8::u32x4 u32x4;
typedef pg8::bf16x8 bf16x8;
typedef float f32x16 __attribute__((ext_vector_type(16)));
#define LAS __attribute__((address_space(3)))

struct Params {
    const float* x; const int* pos; const float* ln_ff1; const float* w_ff1_in; const float* w_ff1_out; const float* ln_mix; const float* ln_ff2;
    const float* w_ff2_in; const float* w_ff2_out; const float* conv_w_in; const float* conv_kernel; const float* conv_w_out;
    const float* attn_w_qkv; const float* attn_sinks; const float* attn_w_o; const float* ln_final;
    float* out; unsigned char* ws;
};

static __device__ const float INV_FREQ[32] = {
    1.000000000e+00f, 7.498942018e-01f, 5.623413324e-01f, 4.216965139e-01f, 3.162277639e-01f, 2.371373773e-01f, 1.778279394e-01f, 1.333521456e-01f,
    1.000000015e-01f, 7.498942316e-02f, 5.623413250e-02f, 4.216964915e-02f, 3.162277490e-02f, 2.371373773e-02f, 1.778279431e-02f, 1.333521400e-02f,
    9.999999776e-03f, 7.498942316e-03f, 5.623413250e-03f, 4.216964822e-03f, 3.162277630e-03f, 2.371373819e-03f, 1.778279431e-03f, 1.333521446e-03f,
    1.000000047e-03f, 7.498941850e-04f, 5.623413017e-04f, 4.216965172e-04f, 3.162277571e-04f, 2.371373703e-04f, 1.778279402e-04f, 1.333521504e-04f};

__device__ __forceinline__ float wave_sum(float v) {
#pragma unroll
    for (int o = 1; o < 64; o <<= 1) v += __shfl_xor(v, o);
    return v;
}
__device__ __forceinline__ void transpose_item(const float* W, int K, int N, const float* gain, bf16_t* WT, int k0, int n0, int drowA, int drowB, LAS float* scr, int lane) {
    f32x4 v[16];
#pragma unroll
    for (int i = 0; i < 16; ++i) v[i] = *(const f32x4*)(W + (size_t)(k0 + 4 * i + (lane >> 4)) * N + n0 + 4 * (lane & 15));
    if (gain) {
#pragma unroll
        for (int i = 0; i < 16; ++i) v[i] = v[i] * gain[k0 + 4 * i + (lane >> 4)];
    }
#pragma unroll
    for (int i = 0; i < 16; ++i) { LAS float* d = scr + (4 * i + (lane >> 4)) * 65 + 4 * (lane & 15); d[0] = v[i][0]; d[1] = v[i][1]; d[2] = v[i][2]; d[3] = v[i][3]; }
    asm volatile("s_waitcnt lgkmcnt(0)" ::: "memory");
    const int c = lane & 7;
#pragma unroll
    for (int j = 0; j < 8; ++j) { const int n = (lane >> 3) + 8 * j; const LAS float* s = scr + (8 * c) * 65 + n;
        u32x4 o; o.x = pg8::cvt_pk_bf16(s[0 * 65], s[1 * 65]); o.y = pg8::cvt_pk_bf16(s[2 * 65], s[3 * 65]); o.z = pg8::cvt_pk_bf16(s[4 * 65], s[5 * 65]); o.w = pg8::cvt_pk_bf16(s[6 * 65], s[7 * 65]);
        const int drow = j < 4 ? drowA + n : drowB + n - 32;
        *(u32x4*)(WT + (size_t)drow * K + k0 + 8 * c) = o; }
    asm volatile("s_waitcnt lgkmcnt(0)" ::: "memory");
}
__device__ __forceinline__ int bt_row(int type, int s) {
    if (type == 1) { const int up = s >= FF, f = up ? s - FF : s; return 256 * (f >> 7) + (up ? 128 : 0) + (f & 127); }
    if (type == 2) { if (s < 1024) return 2048 + s; const int uu = s >= 2048, ch = s - (uu ? 2048 : 1024); return 256 * (ch >> 7) + (uu ? 128 : 0) + (ch & 127); }
    if (type == 3) { if (s >= 1280) return s; const int pn = s >> 8, hh = (s & 255) >> 6, bj = (s & 63) >> 5; return 256 * pn + 128 * bj + 32 * hh; }
    return s;
}
constexpr int IT_FFIN = (D / 64) * (NFFIN / 64), IT_FFOUT = (FF / 64) * (D / 64), IT_CIN = (D / 64) * (NCIN / 64), IT_SQ = (D / 64) * (D / 64), IT_QKV = (D / 64) * (NQKV / 64);
constexpr int IT_LAYER = 2 * (IT_FFIN + IT_FFOUT), IT_FFN_ALL = DEPTH * IT_LAYER, IT_CONV = IT_CIN + IT_SQ, IT_ATTN = IT_QKV + IT_SQ;
constexpr int IT_ALL = IT_FFN_ALL + 2 * IT_CONV + 2 * IT_ATTN;

__device__ __forceinline__ void prologue(const Params& P, LAS unsigned char* lds, int wave, int lane, int G) {
    asm volatile("" : "+v"(lane));
    unsigned char* ws = P.ws;
    LAS float* scr = (LAS float*)(lds + wave * 16640);
    const int gw = blockIdx.x * NWAVES + wave, NGW = G * NWAVES;
    for (int it = gw; it < IT_ALL; it += NGW) {
        int r = it; const float* W; const float* gain = nullptr; bf16_t* WT; int K, N, type = 0;
        if (r < IT_FFN_ALL) {
            const int l = r / IT_LAYER; r -= l * IT_LAYER; const int which = r >= (IT_FFIN + IT_FFOUT); if (which) r -= IT_FFIN + IT_FFOUT;
            if (r < IT_FFIN) { W = (which ? P.w_ff2_in : P.w_ff1_in) + (size_t)l * D * NFFIN; gain = (which ? P.ln_ff2 : P.ln_ff1) + l * D; WT = (bf16_t*)(ws + WS_WFFIN + (size_t)(l * 2 + which) * SZ_WFFIN); K = D; N = NFFIN; type = 1; }
            else { r -= IT_FFIN; W = (which ? P.w_ff2_out : P.w_ff1_out) + (size_t)l * FF * D; WT = (bf16_t*)(ws + WS_WFFOUT + (size_t)(l * 2 + which) * SZ_WFFOUT); K = FF; N = D; }
        } else if (r < IT_FFN_ALL + 2 * IT_CONV) {
            r -= IT_FFN_ALL; const int j = r / IT_CONV; r -= j * IT_CONV;
            if (r < IT_CIN) { W = P.conv_w_in + (size_t)j * D * NCIN; gain = P.ln_mix + (2 * j) * D; WT = (bf16_t*)(ws + WS_WCIN + (size_t)j * SZ_WCIN); K = D; N = NCIN; type = 2; }
            else { r -= IT_CIN; W = P.conv_w_out + (size_t)j * D * D; WT = (bf16_t*)(ws + WS_WCOUT + (size_t)j * SZ_WSQ); K = D; N = D; }
        } else {
            r -= IT_FFN_ALL + 2 * IT_CONV; const int j = r / IT_ATTN; r -= j * IT_ATTN;
            if (r < IT_QKV) { W = P.attn_w_qkv + (size_t)j * D * NQKV; gain = P.ln_mix + (2 * j + 1) * D; WT = (bf16_t*)(ws + WS_WQKV + (size_t)j * SZ_WQKV); K = D; N = NQKV; type = 3; }
            else { r -= IT_QKV; W = P.attn_w_o + (size_t)j * D * D; WT = (bf16_t*)(ws + WS_WO + (size_t)j * SZ_WSQ); K = D; N = D; }
        }
        const int nblk = N / 64, kb = r / nblk, nb = r - kb * nblk;
        transpose_item(W, K, N, gain, WT, 64 * kb, 64 * nb, bt_row(type, 64 * nb), bt_row(type, 64 * nb + 32), scr, lane);
    }
    bf16_t* XB = (bf16_t*)(ws + WS_XB); pg8::u64_t* SS = (pg8::u64_t*)(ws + WS_SS);
    for (int row = gw; row < M; row += 2 * NGW) {
        f32x4 v[2][4];
#pragma unroll
        for (int q = 0; q < 2; ++q)
#pragma unroll
            for (int j = 0; j < 4; ++j) v[q][j] = (row + q * NGW < M) ? ((const f32x4*)(P.x + (size_t)(row + q * NGW) * D) + lane)[64 * j] : (f32x4){0.f, 0.f, 0.f, 0.f};
#pragma unroll
        for (int q = 0; q < 2; ++q) {
            const int r = row + q * NGW; if (r >= M) break;
            unsigned long long* o8 = (unsigned long long*)(XB + (size_t)r * D) + lane;
            float s = 0.f;
#pragma unroll
            for (int j = 0; j < 4; ++j) { const f32x4 w = v[q][j]; s += (w[0] * w[0] + w[1] * w[1]) + (w[2] * w[2] + w[3] * w[3]);
                o8[64 * j] = (unsigned long long)pg8::cvt_pk_bf16(w[0], w[1]) | ((unsigned long long)pg8::cvt_pk_bf16(w[2], w[3]) << 32); }
            s = wave_sum(s);
            if (lane < 16) SS[(size_t)r * 16 + lane] = lane == 0 ? s : 0.f;
        }
    }
    float* CS = (float*)(ws + WS_CS);
    for (int e = gw * 64 + lane; e < M * 32; e += NGW * 64) {
        const int row = e >> 5, i = e & 31;
        const float angf = (float)P.pos[row] * INV_FREQ[i];
        const double a = (double)angf;
        const double kq = __builtin_rint(a * 0.63661977236758134308);
        const double rr = __builtin_fma(-kq, 1.57079632679489661923, a) - kq * 6.123233995736766e-17;
        const double r2 = rr * rr;
        const double sn = rr * (1.0 - r2 / 6.0 * (1.0 - r2 / 20.0 * (1.0 - r2 / 42.0 * (1.0 - r2 / 72.0 * (1.0 - r2 / 110.0 * (1.0 - r2 / 156.0))))));
        const double cn = 1.0 - r2 / 2.0 * (1.0 - r2 / 12.0 * (1.0 - r2 / 30.0 * (1.0 - r2 / 56.0 * (1.0 - r2 / 90.0 * (1.0 - r2 / 132.0 * (1.0 - r2 / 182.0))))));
        const int q = ((int)kq) & 3;
        const double c = (q == 0) ? cn : (q == 1) ? -sn : (q == 2) ? -cn : sn;
        const double s = (q == 0) ? sn : (q == 1) ? cn : (q == 2) ? -sn : -cn;
        *(pg8::f32x2*)(CS + (size_t)e * 2) = (pg8::f32x2){(float)c, (float)s};
    }
}
__device__ __forceinline__ void unpack8(const u32x4 w, float (&f)[8]) {
    f[0] = __uint_as_float(w.x << 16); f[1] = __uint_as_float(w.x & 0xffff0000u); f[2] = __uint_as_float(w.y << 16); f[3] = __uint_as_float(w.y & 0xffff0000u);
    f[4] = __uint_as_float(w.z << 16); f[5] = __uint_as_float(w.z & 0xffff0000u); f[6] = __uint_as_float(w.w << 16); f[7] = __uint_as_float(w.w & 0xffff0000u);
}
__device__ __forceinline__ void conv_phase(const bf16_t* Z, bf16_t* Bg, const float* ck, int tid, int G) {
    asm volatile("" : "+v"(tid));
    const int cg8 = tid & 127, tr = tid >> 7;
    float k0[8], k1[8], k2[8];
    { const f32x4* p = (const f32x4*)(ck + 8 * cg8); const f32x4 a = p[0], b = p[1]; k0[0] = a[0]; k0[1] = a[1]; k0[2] = a[2]; k0[3] = a[3]; k0[4] = b[0]; k0[5] = b[1]; k0[6] = b[2]; k0[7] = b[3]; }
    { const f32x4* p = (const f32x4*)(ck + D + 8 * cg8); const f32x4 a = p[0], b = p[1]; k1[0] = a[0]; k1[1] = a[1]; k1[2] = a[2]; k1[3] = a[3]; k1[4] = b[0]; k1[5] = b[1]; k1[6] = b[2]; k1[7] = b[3]; }
    { const f32x4* p = (const f32x4*)(ck + 2 * D + 8 * cg8); const f32x4 a = p[0], b = p[1]; k2[0] = a[0]; k2[1] = a[1]; k2[2] = a[2]; k2[3] = a[3]; k2[4] = b[0]; k2[5] = b[1]; k2[6] = b[2]; k2[7] = b[3]; }
    for (int c = blockIdx.x; c < M / 64; c += G) {
        const int t0 = c * 64 + tr * 16;
        float z2[8], z1[8];
        if ((t0 & (SEQ - 1)) == 0) {
#pragma unroll
            for (int i = 0; i < 8; ++i) { z2[i] = 0.f; z1[i] = 0.f; }
        } else {
            unpack8(*(const u32x4*)(Z + (size_t)(t0 - 2) * D + 8 * cg8), z2); unpack8(*(const u32x4*)(Z + (size_t)(t0 - 1) * D + 8 * cg8), z1);
        }
#pragma unroll 1
        for (int tb = 0; tb < 16; tb += 8) {
            u32x4 zr[8], br[8];
#pragma unroll
            for (int tt = 0; tt < 8; ++tt) { const size_t off = (size_t)(t0 + tb + tt) * D + 8 * cg8; zr[tt] = *(const u32x4*)(Z + off); br[tt] = *(const u32x4*)(Bg + off); }
#pragma unroll
            for (int tt = 0; tt < 8; ++tt) {
                float zc[8], bg[8], y[8];
                unpack8(zr[tt], zc); unpack8(br[tt], bg);
#pragma unroll
                for (int i = 0; i < 8; ++i) { y[i] = bg[i] * (k0[i] * z2[i] + k1[i] * z1[i] + k2[i] * zc[i]); z2[i] = z1[i]; z1[i] = zc[i]; }
                *(u32x4*)(Bg + (size_t)(t0 + tb + tt) * D + 8 * cg8) = pg8::pack8(y);
            }
        }
    }
}
constexpr int AT_KP = 72, AT_VP = 264, AT_VOFF = 256 * AT_KP * 2;
__device__ __forceinline__ void attn_item(int b, int h, int qc, int qtl, const bf16_t* Q, LAS const unsigned char* lds, const float* sinks, bf16_t* O, int lane) {
    const int ql = lane & 31, hi = lane >> 5, q0 = qc * 128 + qtl * 32;
    const bf16_t* Qrow = Q + (size_t)(b * SEQ + q0 + ql) * D + h * 64 + hi * 8;
    bf16x8 qf[4];
#pragma unroll
    for (int d0 = 0; d0 < 4; ++d0) qf[d0] = *(const bf16x8*)(Qrow + d0 * 16);
    const int pil = (ql & ~12) | ((ql & 4) << 1) | ((ql & 8) >> 1);
    LAS const unsigned char* kb = lds + ((qtl * 32 + pil) * AT_KP + hi * 8) * 2;
    f32x16 s[5];
#pragma unroll
    for (int i = 0; i < 5; ++i) {
#pragma unroll
        for (int r = 0; r < 16; ++r) s[i][r] = 0.f;
#pragma unroll
        for (int d0 = 0; d0 < 4; ++d0) { const bf16x8 kf = *(LAS const bf16x8*)(kb + (i * 32 * AT_KP + d0 * 16) * 2); s[i] = __builtin_amdgcn_mfma_f32_32x32x16_bf16(kf, qf[d0], s[i], 0, 0, 0); }
    }
    const float sk = sinks[h] * pg8::LOG2E_F;
    float mx = sk;
#pragma unroll
    for (int i = 0; i < 5; ++i) {
        const bool tv = (qc > 0 || qtl + i >= 4);
#pragma unroll
        for (int r = 0; r < 16; ++r) {
            const int off = 16 * (r >> 3) + 8 * hi + (r & 7);
            bool ok = tv; if (i == 0) ok = ok && (off > ql); if (i == 4) ok = ok && (off <= ql);
            const float v = ok ? s[i][r] : -INFINITY; s[i][r] = v; mx = fmaxf(mx, v);
        }
    }
    mx = fmaxf(mx, __shfl_xor(mx, 32));
    float l = 0.f;
#pragma unroll
    for (int i = 0; i < 5; ++i)
#pragma unroll
        for (int r = 0; r < 16; ++r) { const float p = __builtin_amdgcn_exp2f(s[i][r] - mx); s[i][r] = p; l += p; }
    l += __shfl_xor(l, 32); l += __builtin_amdgcn_exp2f(sk - mx);
    const float rl = 1.0f / l;
    f32x16 o[2], o2[2];
#pragma unroll
    for (int r = 0; r < 16; ++r) { o[0][r] = 0.f; o[1][r] = 0.f; o2[0][r] = 0.f; o2[1][r] = 0.f; }
    LAS const unsigned char* vb = lds + AT_VOFF + (ql * AT_VP + qtl * 32 + hi * 8) * 2;
#pragma unroll
    for (int i = 0; i < 5; ++i) {
#pragma unroll
        for (int sl = 0; sl < 2; ++sl) {
            u32x4 pw; pw.x = pg8::cvt_pk_bf16(s[i][8 * sl + 0], s[i][8 * sl + 1]); pw.y = pg8::cvt_pk_bf16(s[i][8 * sl + 2], s[i][8 * sl + 3]);
            pw.z = pg8::cvt_pk_bf16(s[i][8 * sl + 4], s[i][8 * sl + 5]); pw.w = pg8::cvt_pk_bf16(s[i][8 * sl + 6], s[i][8 * sl + 7]);
            const bf16x8 pf = __builtin_bit_cast(bf16x8, pw);
#pragma unroll
            for (int dt = 0; dt < 2; ++dt) { const bf16x8 vf = *(LAS const bf16x8*)(vb + (dt * 32 * AT_VP + i * 32 + 16 * sl) * 2);
                if (sl == 0) o[dt] = __builtin_amdgcn_mfma_f32_32x32x16_bf16(vf, pf, o[dt], 0, 0, 0); else o2[dt] = __builtin_amdgcn_mfma_f32_32x32x16_bf16(vf, pf, o2[dt], 0, 0, 0); }
        }
    }
#pragma unroll
    for (int r = 0; r < 16; ++r) { o[0][r] += o2[0][r]; o[1][r] += o2[1][r]; }
    bf16_t* Orow = O + (size_t)(b * SEQ + q0 + ql) * D + h * 64 + 4 * hi;
#pragma unroll
    for (int dt = 0; dt < 2; ++dt)
#pragma unroll
        for (int rr = 0; rr < 4; ++rr) {
            const unsigned lo = pg8::cvt_pk_bf16(o[dt][4 * rr + 0] * rl, o[dt][4 * rr + 1] * rl), hi2 = pg8::cvt_pk_bf16(o[dt][4 * rr + 2] * rl, o[dt][4 * rr + 3] * rl);
            *(unsigned long long*)(Orow + 32 * dt + 8 * rr) = (unsigned long long)lo | ((unsigned long long)hi2 << 32);
        }
}
constexpr int AT_NCH = BATCH * 4 * (SEQ / 128);
__device__ __forceinline__ void attn_load(int c, const bf16_t* Kb, const bf16_t* Vt, int tid, u32x4 (&kreg)[4], u32x4 (&vreg)[4]) {
    const int bk = c / (SEQ / 128), qc = c - bk * (SEQ / 128), kb0 = qc * 128 - 128;
    const bf16_t* kg = Kb + ((size_t)bk * SEQ + kb0) * 64;
    const bf16_t* vg = Vt + (size_t)bk * 64 * SEQ + kb0;
#pragma unroll
    for (int i = 0; i < 4; ++i) {
        const int p = tid + 512 * i;
        if (qc > 0 || (p >> 3) >= 128) kreg[i] = *(const u32x4*)(kg + (size_t)p * 8); else kreg[i] = (u32x4){0u, 0u, 0u, 0u};
        if (qc > 0 || (p & 31) >= 16) vreg[i] = *(const u32x4*)(vg + (size_t)(p >> 5) * SEQ + (p & 31) * 8); else vreg[i] = (u32x4){0u, 0u, 0u, 0u};
    }
}
__device__ __forceinline__ void attn_phase(const bf16_t* Q, const bf16_t* Kb, const bf16_t* Vt, const float* sinks, bf16_t* O, LAS unsigned char* lds, int tid, int wave, int lane, int G) {
    asm volatile("" : "+v"(lane), "+v"(tid));
    u32x4 kreg[4], vreg[4];
    int c = blockIdx.x;
    if (c < AT_NCH) attn_load(c, Kb, Vt, tid, kreg, vreg);
    for (; c < AT_NCH; c += G) {
        asm volatile("s_waitcnt lgkmcnt(0)\n\ts_barrier" ::: "memory");
#pragma unroll
        for (int i = 0; i < 4; ++i) {
            const int p = tid + 512 * i;
            *(LAS u32x4*)(lds + ((p >> 3) * AT_KP + (p & 7) * 8) * 2) = kreg[i];
            *(LAS u32x4*)(lds + AT_VOFF + ((p >> 5) * AT_VP + (p & 31) * 8) * 2) = vreg[i];
        }
        if (c + G < AT_NCH) attn_load(c + G, Kb, Vt, tid, kreg, vreg);
        asm volatile("s_waitcnt lgkmcnt(0)\n\ts_barrier" ::: "memory");
        const int bk = c / (SEQ / 128), qc = c - bk * (SEQ / 128), b = bk >> 2, kvh = bk & 3;
#pragma unroll 1
        for (int it = 0; it < 2; ++it) attn_item(b, kvh * 4 + (wave >> 1), qc, (wave & 1) * 2 + it, Q, lds, sinks, O, lane);
    }
}
__device__ __forceinline__ void final_norm(const bf16_t* __restrict__ XBp, float* __restrict__ out, const float* __restrict__ gfin, int wave, int lane, int G) {
    asm volatile("" : "+v"(lane));
    const int gw = blockIdx.x * NWAVES + wave, NGW = G * NWAVES;
    f32x4 gv[4];
#pragma unroll
    for (int h = 0; h < 2; ++h) { gv[2 * h] = *(const f32x4*)(gfin + 512 * h + 8 * lane); gv[2 * h + 1] = *(const f32x4*)(gfin + 512 * h + 8 * lane + 4); }
    for (int row = gw; row < M; row += 4 * NGW) {
        u32x4 raw[4][2];
#pragma unroll
        for (int q = 0; q < 4; ++q)
#pragma unroll
            for (int h = 0; h < 2; ++h) raw[q][h] = (row + q * NGW < M) ? *(const u32x4*)(XBp + (size_t)(row + q * NGW) * D + 512 * h + 8 * lane) : (u32x4){0u, 0u, 0u, 0u};
#pragma unroll
        for (int q = 0; q < 4; ++q) {
            const int r = row + q * NGW;
            float v[2][8]; float s = 0.f;
#pragma unroll
            for (int h = 0; h < 2; ++h) { pg8::unpack8f(raw[q][h], v[h]);
#pragma unroll
                for (int i = 0; i < 8; ++i) s += v[h][i] * v[h][i]; }
            const float rs = 1.0f / sqrtf(wave_sum(s) * (1.0f / D) + pg8::RMS_EPS_F);
            if (r < M) {
#pragma unroll
                for (int h = 0; h < 2; ++h) {
                    float* o = out + (size_t)r * D + 512 * h + 8 * lane;
                    *(f32x4*)o = (f32x4){v[h][0], v[h][1], v[h][2], v[h][3]} * rs * gv[2 * h];
                    *(f32x4*)(o + 4) = (f32x4){v[h][4], v[h][5], v[h][6], v[h][7]} * rs * gv[2 * h + 1];
                }
            }
        }
    }
}
#define XB_TMO      128
#define XB_XCNT(j)  (256  + 64 * (j))
#define XB_XSUB(j)  (1280 + 64 * (j))
#define XB_XGEN(j)  (2304 + 64 * (j))
#define XB_TOP      3328
#define XB_TOPGEN   3392
#define XCD_BAR_WORDS 3456
#define XB_SPIN_CAP (1u << 18)

__device__ __forceinline__ unsigned xb_ld(unsigned* p)              { return __hip_atomic_load(p, __ATOMIC_RELAXED, __HIP_MEMORY_SCOPE_AGENT); }
__device__ __forceinline__ unsigned xb_add(unsigned* p, unsigned v) { return __hip_atomic_fetch_add(p, v, __ATOMIC_RELAXED, __HIP_MEMORY_SCOPE_AGENT); }
__device__ __forceinline__ unsigned xb_xcc_id() { return (unsigned)__builtin_amdgcn_s_getreg((3 << 11) | 20) & 0xFu; }
#define XB_SPIN(cond, bar) do { unsigned _sp = 0; while (cond) { __builtin_amdgcn_s_sleep(1); \
    if ((++_sp & 255u) == 0u) { if (xb_ld(&(bar)[XB_TMO])) break; if (_sp > XB_SPIN_CAP) { atomicAdd(&(bar)[XB_TMO], 1u); break; } } } } while (0)

struct XcdBarrier {
    unsigned* bar; unsigned x;
    volatile LAS unsigned* st;
};

__device__ __forceinline__ XcdBarrier xcd_barrier_post(unsigned* bar, volatile LAS unsigned* st) {
    XcdBarrier b; b.bar = bar; b.x = xb_xcc_id(); b.st = st;
    if (threadIdx.x == 0) (void)xb_add(&bar[XB_XCNT(b.x)], 1u);
    return b;
}
__device__ __forceinline__ void xcd_barrier_complete(unsigned* bar, unsigned x, unsigned& nloc, unsigned& nx) {
    const unsigned G = gridDim.x * gridDim.y * gridDim.z;
    unsigned sum, cnt, mine, sp = 0u;
    for (;;) {
        sum = 0u; cnt = 0u; mine = 0u;
#pragma unroll
        for (unsigned j = 0; j < 16; ++j) { const unsigned c = xb_ld(&bar[XB_XCNT(j)]); sum += c; cnt += (c > 0u) ? 1u : 0u; mine = (j == x) ? c : mine; }
        if (sum == G) break;
        __builtin_amdgcn_s_sleep(1);
        if ((++sp & 255u) == 0u) { if (xb_ld(&bar[XB_TMO])) break; if (sp > XB_SPIN_CAP) { atomicAdd(&bar[XB_TMO], 1u); break; } }
    }
    nloc = mine > 0u ? mine : 1u; nx = cnt > 0u ? cnt : 1u;
}

__device__ __forceinline__ void xcd_barrier(const XcdBarrier& b) {
    asm volatile("s_waitcnt vmcnt(0)" ::: "memory");
    __syncthreads();
    if (threadIdx.x == 0) {
        unsigned* bar = b.bar;
        __builtin_amdgcn_s_waitcnt(0);
        unsigned nloc = b.st[0], nx = b.st[1];
        if (nloc == 0u) { xcd_barrier_complete(bar, b.x, nloc, nx); b.st[0] = nloc; b.st[1] = nx; }
        const unsigned old = xb_add(&bar[XB_XSUB(b.x)], 1u);
        const unsigned gen = old / nloc;
        if (old + 1u == (gen + 1u) * nloc) {
            __builtin_amdgcn_fence(__ATOMIC_RELEASE, "agent");
            asm volatile("s_waitcnt vmcnt(0)" ::: "memory");
            const unsigned og = xb_add(&bar[XB_TOP], 1u);
            const unsigned tg = og / nx;
            if (og + 1u == (tg + 1u) * nx) xb_add(&bar[XB_TOPGEN], 1u);
            else XB_SPIN(xb_ld(&bar[XB_TOPGEN]) == tg, bar);
            __builtin_amdgcn_fence(__ATOMIC_ACQUIRE, "agent");
            xb_add(&bar[XB_XGEN(b.x)], 1u);
            asm volatile("s_waitcnt vmcnt(0)" ::: "memory");
        } else {
            XB_SPIN(xb_ld(&bar[XB_XGEN(b.x)]) == gen, bar);
            __builtin_amdgcn_fence(__ATOMIC_ACQUIRE, "agent");
            asm volatile("s_waitcnt vmcnt(0)" ::: "memory");
        }
    }
    __syncthreads();
}
#define GSYNC() xcd_barrier(bar)
__global__ void __launch_bounds__(NTHREADS, 2) fwd_megakernel(Params P) {
    extern __shared__ __attribute__((aligned(16))) unsigned char lds_raw[];
    LAS unsigned char* lds = (LAS unsigned char*)lds_raw;
    cg::grid_group grid = cg::this_grid();
    const int tid = threadIdx.x, lane = tid & 63, wave = __builtin_amdgcn_readfirstlane(tid >> 6), G = gridDim.x;
    unsigned char* ws = P.ws;
    bf16_t* XB = (bf16_t*)(ws + WS_XB); pg8::u64_t* SS = (pg8::u64_t*)(ws + WS_SS); const float* CS = (const float*)(ws + WS_CS);
    bf16_t* ACT = (bf16_t*)(ws + WS_BIG);
    bf16_t* Qb = (bf16_t*)(ws + WS_BIG); bf16_t* Kb = (bf16_t*)(ws + WS_BIG + (size_t)M * D * 2); bf16_t* Vt = (bf16_t*)(ws + WS_BIG + (size_t)M * D * 2 + (size_t)M * 256 * 2);
    bf16_t* Ob = (bf16_t*)(ws + WS_BIG + (size_t)M * D * 2 + (size_t)M * 512 * 2);
    bf16_t* Zb = (bf16_t*)(ws + WS_BIG); bf16_t* Bg = (bf16_t*)(ws + WS_BIG + (size_t)M * D * 2);

    unsigned* barw = (unsigned*)(ws + WS_CTL);
    if (blockIdx.x == 0) for (int i = tid; i < XCD_BAR_WORDS; i += NTHREADS) __hip_atomic_store(barw + i, 0u, __ATOMIC_RELAXED, __HIP_MEMORY_SCOPE_AGENT);
    volatile LAS unsigned* bst = (volatile LAS unsigned*)(lds + LDS_BYTES - 64);
    if (tid < 2) bst[tid] = 0u;
    prologue(P, lds, wave, lane, G);
#ifdef PROBE_PRO2
    __syncthreads(); prologue(P, lds, wave, lane, G);
#endif
    __threadfence();
    __syncthreads();
    grid.sync();
    const XcdBarrier bar = xcd_barrier_post(barw, bst);

    for (int st = 0; st < 3 * DEPTH; ++st) {
        const int l = st / 3, sub = st - 3 * l, j = l >> 1;
        const bool is_ffn = sub != 1, is_conv = (l & 1) == 0;
#ifdef PROBE_G1X2
        for (int rep = 0; rep < 2; ++rep) {
#endif
#ifndef NO_G1
        if (is_ffn) {
            const int which = sub == 2;
            pg8::Gemm g{XB, (const bf16_t*)(ws + WS_WFFIN + (size_t)(l * 2 + which) * SZ_WFFIN), M, NFFIN, D};
            pg8::StaticOrder S; S.init(M, NFFIN, G, (int)blockIdx.x);
            pg8::EpiSwiGLU E{ACT, SS, FF, {(LAS float*)(lds + pg8::STAGE_BYTES + 4096 + wave * 512), -1}};
            pg8::gemm_phase<pg8::EpiSwiGLU, pg8::StaticOrder, true, true>(lds, g, S, E);
        }
#endif
#ifndef NO_G2
        if (!is_ffn && is_conv) {
            pg8::Gemm g{XB, (const bf16_t*)(ws + WS_WCIN + (size_t)j * SZ_WCIN), M, NCIN, D};
            pg8::StaticOrder S; S.init(M, NCIN, G, (int)blockIdx.x);
            pg8::EpiConvIn E{Zb, Bg, SS, {(LAS float*)(lds + pg8::STAGE_BYTES + 4096 + wave * 512), -1}};
            pg8::gemm_phase<pg8::EpiConvIn, pg8::StaticOrder, true, true>(lds, g, S, E);
        }
#endif
#ifndef NO_G3
        if (!is_ffn && !is_conv) {
            const bf16_t* Wq = (const bf16_t*)(ws + WS_WQKV + (size_t)j * SZ_WQKV);
            pg8::Gemm g{XB, Wq, M, NQKV, D, Wq + (size_t)1280 * D, XB};
            pg8::QkvOrder S; S.init(M, G, (int)blockIdx.x);
            pg8::EpiQKV E{Qb, Kb, Vt, SS, CS, SEQ, {(LAS float*)(lds + pg8::STAGE_BYTES + 4096 + wave * 512), -1}};
            pg8::gemm_phase<pg8::EpiQKV, pg8::QkvOrder, true, true>(lds, g, S, E);
        }
#endif
        GSYNC();
#ifdef PROBE_G1X2
        }
#endif
        if (!is_ffn) {
#ifndef NO_CONV
            if (is_conv) conv_phase(Zb, Bg, P.conv_kernel + (size_t)j * 3 * D, tid, G);
#endif
#ifndef NO_ATTN
            if (!is_conv) attn_phase(Qb, Kb, Vt, P.attn_sinks + j * 16, Ob, lds, tid, wave, lane, G);
#ifdef PROBE_ATT2
            if (!is_conv) attn_phase(Qb, Kb, Vt, P.attn_sinks + j * 16, Ob, lds, tid, wave, lane, G);
#endif
#endif
            GSYNC();
        }
#ifndef NO_G4
        {
            const bf16_t* A; const bf16_t* Bt; int K; float scale;
            if (is_ffn) { A = ACT; Bt = (const bf16_t*)(ws + WS_WFFOUT + (size_t)(l * 2 + (sub == 2)) * SZ_WFFOUT); K = FF; scale = 0.5f; }
            else if (is_conv) { A = Bg; Bt = (const bf16_t*)(ws + WS_WCOUT + (size_t)j * SZ_WSQ); K = D; scale = 1.0f; }
            else { A = Ob; Bt = (const bf16_t*)(ws + WS_WO + (size_t)j * SZ_WSQ); K = D; scale = 1.0f; }
            pg8::Gemm g{A, Bt, M, D, K};
            pg8::StaticOrder S; S.init(M, D, G, (int)blockIdx.x);
            pg8::EpiResid E{XB, SS, scale};
            pg8::gemm_phase<pg8::EpiResid, pg8::StaticOrder, true, true>(lds, g, S, E);
        }
#endif
        GSYNC();
    }
    final_norm(XB, P.out, P.ln_final, wave, lane, G);
}

extern "C" void kernel_launch(void* const* d_in, const int* in_sizes, int n_in, void* d_out, int out_size, void* d_ws, size_t ws_size, hipStream_t stream) {
    static int grid = 0;
    if (grid == 0) {
        if (n_in != 16 || in_sizes[0] != M * D || out_size != M * D || ws_size < WS_END) { fprintf(stderr, "kernel_launch: unexpected shapes (n_in %d, in0 %d, out %d, ws %zu, need %zu)\n", n_in, n_in > 0 ? in_sizes[0] : -1, out_size, ws_size, (size_t)WS_END); grid = -1; return; }
        int dev = 0, cus = 0, per_cu = 0;
        (void)hipGetDevice(&dev);
        (void)hipDeviceGetAttribute(&cus, hipDeviceAttributeMultiprocessorCount, dev);
        if (hipFuncSetAttribute((const void*)fwd_megakernel, hipFuncAttributeMaxDynamicSharedMemorySize, LDS_BYTES) != hipSuccess) { fprintf(stderr, "kernel_launch: hipFuncSetAttribute failed\n"); grid = -1; return; }
        if (hipOccupancyMaxActiveBlocksPerMultiprocessor(&per_cu, (const void*)fwd_megakernel, NTHREADS, LDS_BYTES) != hipSuccess || per_cu < 1) { fprintf(stderr, "kernel_launch: occupancy query says %d\n", per_cu); per_cu = 1; }
        (void)hipGetLastError();
        grid = cus * per_cu;
    }
    if (grid < 0) return;
    Params p{};
    p.x = (const float*)d_in[0]; p.pos = (const int*)d_in[1]; p.ln_ff1 = (const float*)d_in[2]; p.w_ff1_in = (const float*)d_in[3]; p.w_ff1_out = (const float*)d_in[4];
    p.ln_mix = (const float*)d_in[5]; p.ln_ff2 = (const float*)d_in[6]; p.w_ff2_in = (const float*)d_in[7]; p.w_ff2_out = (const float*)d_in[8];
    p.conv_w_in = (const float*)d_in[9]; p.conv_kernel = (const float*)d_in[10]; p.conv_w_out = (const float*)d_in[11];
    p.attn_w_qkv = (const float*)d_in[12]; p.attn_sinks = (const float*)d_in[13]; p.attn_w_o = (const float*)d_in[14]; p.ln_final = (const float*)d_in[15];
    p.out = (float*)d_out; p.ws = (unsigned char*)d_ws;
    void* args[] = {&p};
    hipError_t e = hipLaunchCooperativeKernel((const void*)fwd_megakernel, dim3(grid), dim3(NTHREADS), args, LDS_BYTES, stream);
    if (e != hipSuccess) fprintf(stderr, "cooperative launch failed: %s (grid %d)\n", hipGetErrorString(e), grid);
}
```
